# Optimizing an MI355X kernel written in HIP

```python
import math
import jax, jax.numpy as jnp
from jax import lax
import numpy as np

D_MODEL = 1024
BATCH = 32
SEQ = 2048
DEPTH = 1

SSM_WIDTH = D_MODEL // 2
SSM_GROUP = 16
SSM_GROUPS = SSM_WIDTH // SSM_GROUP
SSM_STATE = 64
ATTN_HEADS = 8
HEAD_DIM = (D_MODEL // 2) // ATTN_HEADS
ATTN_WIDTH = ATTN_HEADS * HEAD_DIM
MOBA_BLOCK = 256
MOBA_TOPK = 3
Q_CHUNK = 128
D_FF = 4 * D_MODEL
PLE_DIM = 256
RMS_EPS = 1e-6
DT_MIN = 1e-3
DT_MAX = 1e-1
NEG_INF = -1e30
OFF_U = 0
OFF_Q = OFF_U + SSM_WIDTH
OFF_K = OFF_Q + ATTN_WIDTH
OFF_V = OFF_K + ATTN_WIDTH
OFF_GA = OFF_V + ATTN_WIDTH
OFF_GB = OFF_GA + D_MODEL
IN_COLS = OFF_GB + D_MODEL

kernel_name = "hybrid_s5_moba_sqrelu_block"


def rmsnorm(x, g):
    xf = x.astype(jnp.float32)
    y = xf * lax.rsqrt(jnp.mean(xf * xf, axis=-1, keepdims=True) + RMS_EPS)
    return (y * g.astype(jnp.float32)).astype(x.dtype)


def _ssm_combine(e1, e2):
    a1, b1 = e1
    a2, b2 = e2
    return a1 * a2, a2 * b1 + b2


def s5_mixer(u, lam_re, lam_im, log_dt, b_re, b_im, c_re, c_im, d_skip, w_glu, b_glu):
    f32 = jnp.float32
    bsz, seq, _ = u.shape
    uf = u.astype(f32).reshape(bsz, seq, SSM_GROUPS, SSM_GROUP)
    lam = lax.complex(lam_re.astype(f32), lam_im.astype(f32))
    dt = jnp.exp(log_dt.astype(f32))[:, None]
    lam_bar = jnp.exp(lam * dt)
    b_mat = lax.complex(b_re.astype(f32), b_im.astype(f32))
    b_bar = ((lam_bar - 1.0) / lam)[..., None] * b_mat
    bu = jnp.einsum('bsgc,gpc->bsgp', uf.astype(jnp.complex64), b_bar)
    a = jnp.broadcast_to(lam_bar, (1, seq, SSM_GROUPS, SSM_STATE))
    _, states = lax.associative_scan(_ssm_combine, (a, bu), axis=1)
    c_mat = lax.complex(c_re.astype(f32), c_im.astype(f32))
    y = jnp.real(jnp.einsum('gcp,bsgp->bsgc', c_mat, states))
    y = y + d_skip.astype(f32).reshape(SSM_GROUPS, SSM_GROUP) * uf
    y = jax.nn.gelu(y.reshape(bsz, seq, SSM_WIDTH).astype(u.dtype))
    return y * jax.nn.sigmoid(y @ w_glu + b_glu)


def moba_attention(q, k, v):
    f32 = jnp.float32
    bsz, seq, nh, hd = q.shape
    nb = -(-seq // MOBA_BLOCK)
    s_pad = nb * MOBA_BLOCK
    pad = ((0, 0), (0, s_pad - seq), (0, 0), (0, 0))
    q = jnp.pad(q, pad)
    k = jnp.pad(k, pad)
    v = jnp.pad(v, pad)
    kb = k.reshape(bsz, nb, MOBA_BLOCK, nh, hd).transpose(0, 3, 1, 2, 4)
    vb = v.reshape(bsz, nb, MOBA_BLOCK, nh, hd).transpose(0, 3, 1, 2, 4)
    scale = hd ** -0.5
    n_sel = min(MOBA_TOPK, nb - 1)
    n_chunks = s_pad // Q_CHUNK
    qc = q.reshape(bsz * n_chunks, Q_CHUNK, nh, hd)
    b_ids = jnp.repeat(jnp.arange(bsz, dtype=jnp.int32), n_chunks)
    c_ids = jnp.tile(jnp.arange(n_chunks, dtype=jnp.int32), bsz)
    if n_sel > 0:
        k_mean = jnp.mean(kb.astype(f32), axis=3)
        gate = jnp.einsum('bshd,bhnd->bshn', q.astype(f32), k_mean)
        qblk = jnp.arange(s_pad) // MOBA_BLOCK
        past = jnp.arange(nb)[None, :] < qblk[:, None]
        gate = jnp.where(past[None, :, None, :], gate, NEG_INF)
        _, sel = lax.top_k(gate, n_sel)
        sel_c = sel.astype(jnp.int32).reshape(bsz * n_chunks, Q_CHUNK, nh, n_sel)
    else:
        sel_c = jnp.zeros((bsz * n_chunks, Q_CHUNK, nh, 0), jnp.int32)
    heads = jnp.arange(nh)[None, :, None]

    def step(args):
        qq, ss, b, c = args
        k_b = kb[b]
        v_b = vb[b]
        own = (c * Q_CHUNK) // MOBA_BLOCK
        pos_q = c * Q_CHUNK + jnp.arange(Q_CHUNK)
        pos_k = own * MOBA_BLOCK + jnp.arange(MOBA_BLOCK)
        k_own = k_b[:, own].astype(f32)
        v_own = v_b[:, own].astype(f32)
        qf = qq.astype(f32) * scale
        s_own = jnp.einsum('qhd,hkd->qhk', qf, k_own)
        causal = (pos_k[None, :] <= pos_q[:, None])[:, None, :]
        s_own = jnp.where(causal, s_own, NEG_INF)
        if n_sel > 0:
            k_sel = k_b[heads, ss].astype(f32)
            v_sel = v_b[heads, ss].astype(f32)
            s_sel = jnp.einsum('qhd,qhnkd->qhnk', qf, k_sel)
            valid = (ss < own)[..., None]
            s_sel = jnp.where(valid, s_sel, NEG_INF)
            n_k = n_sel * MOBA_BLOCK
            scores = jnp.concatenate([s_sel.reshape(Q_CHUNK, nh, n_k), s_own], axis=-1)
            probs = jax.nn.softmax(scores, axis=-1)
            p_sel = probs[..., :n_k].reshape(Q_CHUNK, nh, n_sel, MOBA_BLOCK)
            p_own = probs[..., n_k:]
            out = (jnp.einsum('qhnk,qhnkd->qhd', p_sel, v_sel)
                   + jnp.einsum('qhk,hkd->qhd', p_own, v_own))
        else:
            probs = jax.nn.softmax(s_own, axis=-1)
            out = jnp.einsum('qhk,hkd->qhd', probs, v_own)
        return out.astype(qq.dtype)

    outs = lax.map(step, (qc, sel_c, b_ids, c_ids))
    outs = outs.reshape(bsz, s_pad, nh * hd)
    return outs[:, :seq]


def setup_inputs(seed: int = 0) -> dict:
    key = jax.random.key(seed)
    ks = jax.random.split(key, 26)
    f32 = jnp.float32
    L = DEPTH

    def nrm(k, shape, scale):
        return jax.random.normal(k, shape, f32) * scale

    def gain(k):
        return 1.0 + 0.01 * jax.random.normal(k, (L, D_MODEL), f32)

    n_idx = jnp.arange(SSM_STATE, dtype=f32)
    return {
        "x": nrm(ks[0], (BATCH, SEQ, D_MODEL), 1.0),
        "p": nrm(ks[1], (L, BATCH, SEQ, PLE_DIM), 1.0),
        "g_pre_mix": gain(ks[2]),
        "w_in": nrm(ks[3], (L, D_MODEL, IN_COLS), D_MODEL ** -0.5),
        "ssm_lam_re": -0.5 + 0.01 * jax.random.normal(ks[4], (L, SSM_GROUPS, SSM_STATE), f32),
        "ssm_lam_im": math.pi * n_idx + 0.01 * jax.random.normal(ks[5], (L, SSM_GROUPS, SSM_STATE), f32),
        "ssm_log_dt": jax.random.uniform(ks[6], (L, SSM_GROUPS), f32, math.log(DT_MIN), math.log(DT_MAX)),
        "ssm_b_re": nrm(ks[7], (L, SSM_GROUPS, SSM_STATE, SSM_GROUP), (2 * SSM_GROUP) ** -0.5),
        "ssm_b_im": nrm(ks[8], (L, SSM_GROUPS, SSM_STATE, SSM_GROUP), (2 * SSM_GROUP) ** -0.5),
        "ssm_c_re": nrm(ks[9], (L, SSM_GROUPS, SSM_GROUP, SSM_STATE), (2 * SSM_STATE) ** -0.5),
        "ssm_c_im": nrm(ks[10], (L, SSM_GROUPS, SSM_GROUP, SSM_STATE), (2 * SSM_STATE) ** -0.5),
        "ssm_d": nrm(ks[11], (L, SSM_WIDTH), 1.0),
        "w_glu": nrm(ks[12], (L, SSM_WIDTH, SSM_WIDTH), SSM_WIDTH ** -0.5),
        "b_glu": nrm(ks[13], (L, SSM_WIDTH), 0.01),
        "w_branch_a": nrm(ks[14], (L, SSM_WIDTH, D_MODEL), SSM_WIDTH ** -0.5),
        "w_branch_b": nrm(ks[15], (L, ATTN_WIDTH, D_MODEL), ATTN_WIDTH ** -0.5),
        "w_out": nrm(ks[16], (L, D_MODEL, D_MODEL), D_MODEL ** -0.5),
        "g_post_mix": gain(ks[17]),
        "g_pre_mlp": gain(ks[18]),
        "w_mlp1": nrm(ks[19], (L, D_MODEL, D_FF), D_MODEL ** -0.5),
        "w_mlp2": nrm(ks[20], (L, D_FF, D_MODEL), D_FF ** -0.5),
        "g_post_mlp": gain(ks[21]),
        "w_ple": nrm(ks[22], (L, PLE_DIM, D_MODEL), PLE_DIM ** -0.5),
        "w_ple_gate": nrm(ks[23], (L, D_MODEL, D_MODEL), D_MODEL ** -0.5),
        "g_ple": gain(ks[24]),
    }


def reference(x, p, g_pre_mix, w_in, ssm_lam_re, ssm_lam_im, ssm_log_dt, ssm_b_re, ssm_b_im,
              ssm_c_re, ssm_c_im, ssm_d, w_glu, b_glu, w_branch_a, w_branch_b, w_out,
              g_post_mix, g_pre_mlp, w_mlp1, w_mlp2, g_post_mlp, w_ple, w_ple_gate, g_ple):
    bsz, seq, _ = x.shape
    for i in range(DEPTH):
        h = rmsnorm(x, g_pre_mix[i])
        z = h @ w_in[i]
        u = z[..., OFF_U:OFF_Q]
        q = z[..., OFF_Q:OFF_K].reshape(bsz, seq, ATTN_HEADS, HEAD_DIM)
        k = z[..., OFF_K:OFF_V].reshape(bsz, seq, ATTN_HEADS, HEAD_DIM)
        v = z[..., OFF_V:OFF_GA].reshape(bsz, seq, ATTN_HEADS, HEAD_DIM)
        gate_a = jax.nn.sigmoid(z[..., OFF_GA:OFF_GB])
        gate_b = jax.nn.sigmoid(z[..., OFF_GB:IN_COLS])
        y_a = s5_mixer(u, ssm_lam_re[i], ssm_lam_im[i], ssm_log_dt[i], ssm_b_re[i], ssm_b_im[i],
                       ssm_c_re[i], ssm_c_im[i], ssm_d[i], w_glu[i], b_glu[i]) @ w_branch_a[i]
        y_b = moba_attention(q, k, v) @ w_branch_b[i]
        mixed = (gate_a * y_a + gate_b * y_b) @ w_out[i]
        x = x + rmsnorm(mixed, g_post_mix[i])
        hm = rmsnorm(x, g_pre_mlp[i])
        f = jnp.square(jax.nn.relu(hm @ w_mlp1[i])) @ w_mlp2[i]
        x = x + rmsnorm(f, g_post_mlp[i])
        e = (p[i] @ w_ple[i]) * jax.nn.sigmoid(x @ w_ple_gate[i])
        x = x + rmsnorm(e, g_ple[i])
    return x
```

```cpp
#include <hip/hip_runtime.h>
#include <hip/hip_cooperative_groups.h>
#include <cstdio>
#include <cstdint>
namespace cg = cooperative_groups;

#ifndef MK_DEBUG
#define MK_DEBUG 0
#endif
#ifndef MK_NTGATE
#define MK_NTGATE 1
#endif
#ifndef MK_NT
#define MK_NT 1
#endif
#ifndef MK_LAUNCHES
#define MK_LAUNCHES 1
#endif

#define LAS __attribute__((address_space(3)))
typedef unsigned short bf16_t;
typedef short bf16x8 __attribute__((ext_vector_type(8)));
typedef short s16x4 __attribute__((ext_vector_type(4)));
typedef float f32x4 __attribute__((ext_vector_type(4)));
typedef float f32x16 __attribute__((ext_vector_type(16)));
typedef unsigned u32x4 __attribute__((ext_vector_type(4)));
typedef unsigned u32x2 __attribute__((ext_vector_type(2)));
typedef float f32x2_t __attribute__((ext_vector_type(2)));
typedef __bf16 bf16x2_t __attribute__((ext_vector_type(2)));

constexpr int BATCH = 32, SEQ = 2048, DM = 1024, M_TOK = BATCH * SEQ;
constexpr int SSM_W = 512, NG = 32, GC = 16, NSTATE = 64;
constexpr int NHEAD = 8, HD = 64, ATT_W = 512, MBLK = 256, NBLK = 8;
constexpr int DFF = 4096, PLE = 256, INC = 4096;
constexpr float RMS_EPS = 1e-6f;
constexpr int CL = 32;
constexpr int NCH = SEQ / CL;
constexpr int NROW_G = BATCH * NCH;
constexpr int APK = 128 + CL * GC;
constexpr int NM_PANELS = M_TOK / 256;
constexpr float QSCALE = 0.125f * 1.4426950408889634f;

constexpr size_t MiB = 1u << 20;
constexpr size_t WS_WIN = 0, WS_W1 = 8 * MiB, WS_W2 = 16 * MiB, WS_WOUT = 24 * MiB, WS_WPG = 26 * MiB, WS_WA = 28 * MiB, WS_WB = 29 * MiB;
constexpr size_t WS_WGLU = 30 * MiB, WS_WPLE = 30 * MiB + 512 * 1024, WS_WS1 = 31 * MiB, WS_WS2 = 39 * MiB;
constexpr size_t WS_AL = 59 * MiB, WS_R0 = 59 * MiB + 65536, WS_R2 = 59 * MiB + 65536 + 262144, WS_RSQ = 60 * MiB, WS_PB = 64 * MiB;
constexpr size_t WS_SC = 96 * MiB, WS_SA = 736 * MiB, WS_SB = 864 * MiB;
constexpr size_t WS_H = WS_SC, WS_T1 = WS_SC;
constexpr size_t WS_PW = 224 * MiB;
constexpr size_t WS_GA = WS_SA, WS_MIXIN = WS_SA, WS_F = WS_SA, WS_EE = WS_SA;
constexpr size_t WS_GB = WS_SB, WS_MIXED = WS_SB, WS_X2B = WS_SB;
constexpr size_t WS_AP = 224 * MiB, WS_E = 304 * MiB, WS_Q = 336 * MiB, WS_K = 400 * MiB, WS_V = 464 * MiB, WS_Y = 528 * MiB, WS_ATT = 592 * MiB;
constexpr size_t WS_GLU = WS_Q;
constexpr int HID_LD = DFF;
constexpr size_t WS_HID = 224 * MiB;
constexpr size_t WS_KMEAN = 992 * MiB;
constexpr size_t WS_BAR = 993 * MiB;
constexpr size_t WS_END = 994 * MiB;
static_assert(WS_V - WS_K == WS_K - WS_Q, "Q|K|V equally spaced");

__device__ __forceinline__ unsigned pk_bf16(float lo, float hi) { f32x2_t v = {lo, hi}; bf16x2_t b = __builtin_convertvector(v, bf16x2_t); return __builtin_bit_cast(unsigned, b); }
__device__ __forceinline__ float bf_lo(unsigned w) { return __uint_as_float(w << 16); }
__device__ __forceinline__ float bf_hi(unsigned w) { return __uint_as_float(w & 0xffff0000u); }
__device__ __forceinline__ float bf_round(float x) { return bf_lo(pk_bf16(x, 0.f) & 0xffffu); }
__device__ __forceinline__ float fsigmoid(float x) { return __builtin_amdgcn_rcpf(1.0f + __builtin_amdgcn_exp2f(-1.4426950408889634f * x)); }
__device__ __forceinline__ float gelu_tanh(float y) { const float z = 0.7978845608028654f * (y + 0.044715f * y * y * y); return y * __builtin_amdgcn_rcpf(1.0f + __builtin_amdgcn_exp2f(-2.885390081777927f * z)); }
__device__ __forceinline__ float wave_sum(float v) {
#pragma unroll
    for (int o = 1; o < 64; o <<= 1) v += __shfl_xor(v, o);
    return v;
}
__device__ __forceinline__ void unpack8(const u32x4 w, float* f) { f[0] = bf_lo(w.x); f[1] = bf_hi(w.x); f[2] = bf_lo(w.y); f[3] = bf_hi(w.y); f[4] = bf_lo(w.z); f[5] = bf_hi(w.z); f[6] = bf_lo(w.w); f[7] = bf_hi(w.w); }

namespace pg8 {
constexpr int BM = 256, BK = 64, HALF = 128, HTB = HALF * BK * 2, STAGE_BYTES = 8 * HTB, NXCD = 8, WGM = 8;
__device__ __forceinline__ int lds_byte(int r, int c) { const int st = (r >> 4) * 2 + (c >> 5), rr = r & 15, cc = c & 31, ob = rr * 64 + cc * 2; return st * 1024 + (ob ^ (((ob >> 9) & 1) << 5)); }
__device__ __forceinline__ void stage_rc(int b, int& R, int& C) { const int st = b / 1024, sb = b % 1024, swz = sb ^ (((sb >> 9) & 1) << 5); R = (st >> 1) * 16 + swz / 64; C = (st & 1) * 32 + (swz % 64) / 2; }
__device__ __forceinline__ int perm32(int rho) { const int n = rho >> 4, i = rho & 15; return 8 * (i >> 2) + 4 * n + (i & 3); }

struct Unit { int pm, pn; };
struct Gemm { const bf16_t* A; const bf16_t* Bt; int lda, ldb, K, nM, nN, pmPerGroup; size_t gstrideB; };

struct StaticOrder {
    int nM, nN, nwg, G, c;
    __device__ void init(int nM_, int nN_, int G_, int c_) { nM = nM_; nN = nN_; nwg = nM * nN; G = G_; c = c_; }
    __device__ bool next(int i, Unit& u) const {
        const long L = (long)i * G + c; if (L >= nwg) return false;
        int wgid = (int)L; { const int q = nwg / NXCD, r = nwg % NXCD, xcd = wgid % NXCD, off = wgid / NXCD; wgid = (xcd < r ? xcd * (q + 1) : r * (q + 1) + (xcd - r) * q) + off; }
        const int nig = WGM * nN, gid = wgid / nig, fm = gid * WGM, gsz = (nM - fm) < WGM ? (nM - fm) : WGM;
        u.pm = fm + ((wgid % nig) % gsz); u.pn = (wgid % nig) / gsz; return true;
    }
};

struct PanelOrder {
    int pm, nN;
    __device__ bool next(int i, Unit& u) const { if (i >= nN) return false; int pmo = pm; asm volatile("" : "+s"(pmo)); u.pm = pmo; u.pn = i; return true; }
};
template <class Epi, class Sched>
__device__ __forceinline__ void gemm_phase(LAS unsigned char* lds, const Gemm g, const Sched& S, const Epi& E) {
    const int tid = threadIdx.x, wid = __builtin_amdgcn_readfirstlane(tid >> 6), lane = tid & 63, wr = wid >> 2, wc = wid & 3, fr = lane & 15, fq = lane >> 4;
    int K = g.K; asm volatile("" : "+s"(K));
    const int nt = K / BK;
    unsigned voffA[2], voffB[2];
#pragma unroll
    for (int i = 0; i < 2; ++i) { int R, C; stage_rc(tid * 16 + i * 8192, R, C); const int Rb = Epi::PERM ? ((R & ~31) + perm32(R & 31)) : R;
        voffA[i] = (unsigned)(R * g.lda + C) * 2u; voffB[i] = (unsigned)(Rb * g.ldb + C) * 2u; }
    const size_t kstep = (size_t)(BK * 2);
    const size_t hstepA = (size_t)HALF * g.lda * 2, tstepA = 2 * hstepA;
    const size_t hstepB = (size_t)HALF * g.ldb * 2, tstepB = 2 * hstepB;
    const unsigned ldsw = (unsigned)wid * 1024u;
    const int aoff = lds_byte(wr * 64 + fr, fq * 8), boff = lds_byte(wc * 32 + fr, fq * 8);
#define PG8_SA(b, h) (((b) * 2 + (h)) * HTB)
#define PG8_SB(b, h) ((4 + (b) * 2 + (h)) * HTB)
#define PG8_STAGE(bufoff, gbase, voff) do { _Pragma("unroll") for (int _i = 0; _i < 2; ++_i) \
        __builtin_amdgcn_global_load_lds((const unsigned*)((const char*)(gbase) + (voff)[_i]), (LAS unsigned*)(lds + (bufoff) + ldsw + _i * 8192), 16, 0, 0); } while (0)
#define PG8_LDA(dst, b, h) do { _Pragma("unroll") for (int m = 0; m < 4; ++m) _Pragma("unroll") for (int k = 0; k < 2; ++k) dst[m][k] = *(const LAS bf16x8*)(lds + PG8_SA(b, h) + aoff + m * 2048 + k * 1024); } while (0)
#define PG8_LDB(dst, b, h) do { _Pragma("unroll") for (int n = 0; n < 2; ++n) _Pragma("unroll") for (int k = 0; k < 2; ++k) dst[n][k] = *(const LAS bf16x8*)(lds + PG8_SB(b, h) + boff + n * 2048 + k * 1024); } while (0)
#define PG8_MMA(ai, bj, At, Bt) do { __builtin_amdgcn_s_setprio(1); _Pragma("unroll") for (int m = 0; m < 4; ++m) _Pragma("unroll") for (int n = 0; n < 2; ++n) _Pragma("unroll") for (int k = 0; k < 2; ++k) \
        acc[ai][bj][m][n] = __builtin_amdgcn_mfma_f32_16x16x32_bf16(Bt[n][k], At[m][k], acc[ai][bj][m][n], 0, 0, 0); __builtin_amdgcn_s_setprio(0); } while (0)
#define PG8_WAIT_V(n) asm volatile("s_waitcnt vmcnt(" #n ")" ::: "memory")
#define PG8_WAIT_L(n) asm volatile("s_waitcnt lgkmcnt(" #n ")" ::: "memory")
#define PG8_BAR __builtin_amdgcn_s_barrier()
#define PG8_SCHED __builtin_amdgcn_sched_barrier(0)
#define PG8_ABASE(u) ((const char*)g.A + (size_t)(u).pm * tstepA)
#define PG8_BBASE(u) ((const char*)g.Bt + (size_t)((u).pm / g.pmPerGroup) * g.gstrideB * 2 + (size_t)(u).pn * tstepB)
    Unit cur, nxt; int ui = 0;
    if (!S.next(0, cur)) return;
    f32x4 acc[2][2][4][2];
#pragma unroll
    for (int a = 0; a < 2; ++a)
#pragma unroll
        for (int b = 0; b < 2; ++b)
#pragma unroll
            for (int m = 0; m < 4; ++m)
#pragma unroll
                for (int n = 0; n < 2; ++n) acc[a][b][m][n] = (f32x4){0.f, 0.f, 0.f, 0.f};
    bf16x8 At[4][2], B0[2][2], B1[2][2];
    const char* cA = PG8_ABASE(cur); const char* cB = PG8_BBASE(cur);
    PG8_STAGE(PG8_SB(0, 0), cB, voffB); PG8_STAGE(PG8_SB(0, 1), cB + hstepB, voffB); PG8_STAGE(PG8_SA(0, 0), cA, voffA); PG8_STAGE(PG8_SA(0, 1), cA + hstepA, voffA);
    if (wr == 1) PG8_BAR;
    PG8_WAIT_V(2); PG8_BAR;
    PG8_STAGE(PG8_SB(1, 0), cB + kstep, voffB); PG8_STAGE(PG8_SA(1, 0), cA + kstep, voffA); PG8_STAGE(PG8_SB(1, 1), cB + hstepB + kstep, voffB);
    PG8_WAIT_V(6); PG8_BAR;
    for (;;) {
        const bool has_next = S.next(ui + 1, nxt);
        const char* nA = has_next ? PG8_ABASE(nxt) : cA; const char* nB = has_next ? PG8_BBASE(nxt) : cB;
        for (int t = 0; t < nt; t += 2) {
            const bool last = (t == nt - 2);
            const char* a1 = cA + (size_t)(t + 1) * kstep;
            const char* a2 = last ? nA : cA + (size_t)(t + 2) * kstep; const char* b2 = last ? nB : cB + (size_t)(t + 2) * kstep;
            const char* a3 = a2 + kstep; const char* b3 = b2 + kstep;
            PG8_LDB(B0, 0, 0); PG8_LDB(B1, 0, 1); PG8_SCHED; PG8_LDA(At, 0, 0); PG8_STAGE(PG8_SA(1, 1), a1 + hstepA, voffA);
            PG8_WAIT_V(8); PG8_WAIT_L(0); PG8_BAR; PG8_MMA(0, 0, At, B0); PG8_MMA(0, 1, At, B1); PG8_BAR; PG8_SCHED;
            PG8_LDA(At, 0, 1); PG8_STAGE(PG8_SB(0, 0), b2, voffB); PG8_STAGE(PG8_SB(0, 1), b2 + hstepB, voffB); PG8_STAGE(PG8_SA(0, 0), a2, voffA);
            PG8_WAIT_V(8); PG8_WAIT_L(0); PG8_BAR; PG8_MMA(1, 0, At, B0); PG8_MMA(1, 1, At, B1); PG8_BAR; PG8_SCHED;
            PG8_LDB(B0, 1, 0); PG8_LDB(B1, 1, 1); PG8_SCHED; PG8_LDA(At, 1, 0); PG8_STAGE(PG8_SA(0, 1), a2 + hstepA, voffA);
            PG8_WAIT_V(8); PG8_WAIT_L(0); PG8_BAR; PG8_MMA(0, 0, At, B0); PG8_MMA(0, 1, At, B1); PG8_BAR; PG8_SCHED;
            PG8_LDA(At, 1, 1); PG8_STAGE(PG8_SB(1, 0), b3, voffB); PG8_STAGE(PG8_SB(1, 1), b3 + hstepB, voffB); PG8_STAGE(PG8_SA(1, 0), a3, voffA);
            PG8_WAIT_V(8); PG8_WAIT_L(0); PG8_BAR; PG8_MMA(1, 0, At, B0); PG8_MMA(1, 1, At, B1); PG8_BAR; PG8_SCHED;
        }
        if (wr == 0) PG8_BAR;
        E(acc, cur, wr, wc, fr, fq);
        if (!has_next) break;
#pragma unroll
        for (int a = 0; a < 2; ++a)
#pragma unroll
            for (int b = 0; b < 2; ++b)
#pragma unroll
                for (int m = 0; m < 4; ++m)
#pragma unroll
                    for (int n = 0; n < 2; ++n) acc[a][b][m][n] = (f32x4){0.f, 0.f, 0.f, 0.f};
        cur = nxt; cA = nA; cB = nB; ++ui;
        if (wr == 1) PG8_BAR;
    }
    PG8_WAIT_V(0);
    PG8_BAR;
#undef PG8_SA
#undef PG8_SB
#undef PG8_STAGE
#undef PG8_LDA
#undef PG8_LDB
#undef PG8_MMA
#undef PG8_WAIT_V
#undef PG8_WAIT_L
#undef PG8_BAR
#undef PG8_SCHED
#undef PG8_ABASE
#undef PG8_BBASE
}
}

typedef const f32x4 (&AccRef)[2][2][4][2];
#ifndef MK_NTQKV
#define MK_NTQKV 0
#endif
#if MK_NTQKV
#define EPI_ST(p, v) __builtin_nontemporal_store((v), (p))
#else
#define EPI_ST(p, v) (*(p) = (v))
#endif
#define EPI_ROWS(ai, m) for (int ai = 0; ai < 2; ++ai) _Pragma("unroll") for (int m = 0; m < 4; ++m)
__device__ __forceinline__ u32x4 pack8(const f32x4 a, const f32x4 b) { u32x4 w; w.x = pk_bf16(a[0], a[1]); w.y = pk_bf16(a[2], a[3]); w.z = pk_bf16(b[0], b[1]); w.w = pk_bf16(b[2], b[3]); return w; }

struct EpiIn {
    static constexpr bool PERM = true;
    bf16_t* Ap; bf16_t* Q; bf16_t* Kb; bf16_t* Vb; bf16_t* GA; bf16_t* GB; float* kmean; const float* r0;
    __device__ __forceinline__ void operator()(AccRef acc_, const pg8::Unit& u, int wr, int wc, int fr, int fq) const {
        const int pn = u.pn, row0 = u.pm * 256 + wr * 64 + fr, colw = wc * 32 + 8 * fq;
        f32x4 acc[2][2][4][2];
#pragma unroll
        EPI_ROWS(ai, m) { const float rs = r0[row0 + ai * 128 + m * 16];
#pragma unroll
            for (int bj = 0; bj < 2; ++bj) { acc[ai][bj][m][0] = acc_[ai][bj][m][0] * rs; acc[ai][bj][m][1] = acc_[ai][bj][m][1] * rs; } }
        if (pn < 2) {
            const int b = u.pm >> 3, s0 = (u.pm & 7) * 256 + wr * 64 + fr;
#pragma unroll
            EPI_ROWS(ai, m) { const int s = s0 + ai * 128 + m * 16, n = b * NCH + (s >> 5), i = s & 31;
#pragma unroll
                for (int bj = 0; bj < 2; ++bj) { const int col = pn * 256 + bj * 128 + colw, gg = col >> 4, c0 = col & 15;
                    *(u32x4*)(Ap + ((size_t)(gg * NROW_G + n)) * APK + 128 + i * 16 + c0) = pack8(acc[ai][bj][m][0], acc[ai][bj][m][1]); } }
        } else if (pn < 8) {
            bf16_t* dst = Q + (size_t)((pn - 2) >> 1) * ((WS_K - WS_Q) / 2); const int cbase = (pn & 1) * 256 + colw; const float sc = (pn < 4) ? QSCALE : 1.0f;
#pragma unroll
            EPI_ROWS(ai, m) { const size_t row = (size_t)(row0 + ai * 128 + m * 16);
#pragma unroll
                for (int bj = 0; bj < 2; ++bj) EPI_ST((u32x4*)(dst + row * 512 + cbase + bj * 128), pack8(acc[ai][bj][m][0] * sc, acc[ai][bj][m][1] * sc)); }
            if (pn == 4 || pn == 5) {
                f32x4 c00 = (f32x4){0.f, 0.f, 0.f, 0.f}, c01 = c00, c10 = c00, c11 = c00;
#pragma unroll
                EPI_ROWS(ai, m) { c00 += acc[ai][0][m][0]; c01 += acc[ai][0][m][1]; c10 += acc[ai][1][m][0]; c11 += acc[ai][1][m][1]; }
#pragma unroll
                for (int j = 0; j < 4; ++j) {
                    float a = c00[j], b = c01[j], c = c10[j], d = c11[j];
#pragma unroll
                    for (int o = 1; o < 16; o <<= 1) { a += __shfl_xor(a, o); b += __shfl_xor(b, o); c += __shfl_xor(c, o); d += __shfl_xor(d, o); }
                    c00[j] = a; c01[j] = b; c10[j] = c; c11[j] = d;
                }
                if (fr == 0) {
                    float* km = kmean + ((size_t)wr * NM_PANELS + u.pm) * 512 + cbase;
                    *(f32x4*)(km) = c00 * (1.0f / 256.0f); *(f32x4*)(km + 4) = c01 * (1.0f / 256.0f); *(f32x4*)(km + 128) = c10 * (1.0f / 256.0f); *(f32x4*)(km + 132) = c11 * (1.0f / 256.0f);
                }
            }
        } else {
            bf16_t* dst = GA + (size_t)((pn - 8) >> 2) * ((WS_GB - WS_GA) / 2); const int cbase = ((pn - 8) & 3) * 256 + colw;
#pragma unroll
            EPI_ROWS(ai, m) { const size_t row = (size_t)(row0 + ai * 128 + m * 16);
#pragma unroll
                for (int bj = 0; bj < 2; ++bj) { f32x4 a = acc[ai][bj][m][0], c = acc[ai][bj][m][1];
#pragma unroll
                    for (int j = 0; j < 4; ++j) { a[j] = fsigmoid(a[j]); c[j] = fsigmoid(c[j]); }
#if MK_NTGATE
                    __builtin_nontemporal_store(pack8(a, c), (u32x4*)(dst + row * 1024 + cbase + bj * 128)); } }
#else
                    EPI_ST((u32x4*)(dst + row * 1024 + cbase + bj * 128), pack8(a, c)); } }
#endif
        }
    }
};
struct EpiSsm1 {
    static constexpr bool PERM = false;
    float* E;
    __device__ __forceinline__ void operator()(AccRef acc, const pg8::Unit& u, int wr, int wc, int fr, int fq) const {
        const int row0 = u.pm * 256 + wr * 64 + fr, col0 = wc * 32 + 4 * fq;
#pragma unroll
        EPI_ROWS(ai, m) { float* rp = E + (size_t)(row0 + ai * 128 + m * 16) * 128 + col0;
#pragma unroll
            for (int n = 0; n < 2; ++n) *(f32x4*)(rp + n * 16) = acc[ai][0][m][n]; }
    }
};
struct EpiSsm2 {
    static constexpr bool PERM = true;
    const bf16_t* Ap; const float* dsk; bf16_t* Y;
    __device__ __forceinline__ void operator()(AccRef acc, const pg8::Unit& u, int wr, int wc, int fr, int fq) const {
        const int gg = u.pm >> 3, nl0 = (u.pm & 7) * 256 + wr * 64 + fr;
#pragma unroll
        for (int bj = 0; bj < 2; ++bj) {
            const int col = u.pn * 256 + bj * 128 + wc * 32 + 8 * fq, i = col >> 4, c0 = col & 15;
            const f32x4 d0 = *(const f32x4*)(dsk + gg * 16 + c0), d1 = *(const f32x4*)(dsk + gg * 16 + c0 + 4);
#pragma unroll
            EPI_ROWS(ai, m) { const int n = nl0 + ai * 128 + m * 16, b = n >> 6, ch = n & 63;
                const u32x4 uw = *(const u32x4*)(Ap + ((size_t)(gg * NROW_G + n)) * APK + 128 + col);
                float uf[8]; unpack8(uw, uf);
                f32x4 a = acc[ai][bj][m][0], c = acc[ai][bj][m][1];
#pragma unroll
                for (int j = 0; j < 4; ++j) { a[j] = gelu_tanh(a[j] + d0[j] * uf[j]); c[j] = gelu_tanh(c[j] + d1[j] * uf[4 + j]); }
                *(u32x4*)(Y + ((size_t)(b * SEQ + ch * CL + i)) * SSM_W + gg * 16 + c0) = pack8(a, c);
                if (m & 1) asm volatile("" ::: "memory"); }
        }
    }
};
enum { EM_PLAIN = 0, EM_GLU = 1, EM_GATE = 2, EM_GATEADD = 3, EM_RELU2 = 4, EM_MULSIG = 5 };
template <int MODE, bool ROWSQ>
struct EpiGen {
    static constexpr bool PERM = true;
    bf16_t* O; int ldc; const bf16_t* X1; const bf16_t* X2; const float* bias; float* rsq;
    __device__ __forceinline__ void operator()(AccRef acc, const pg8::Unit& u, int wr, int wc, int fr, int fq) const {
        const int row0 = u.pm * 256 + wr * 64 + fr, col0 = u.pn * 256 + wc * 32 + 8 * fq;
        float bv[2][8];
        if (MODE == EM_GLU) {
#pragma unroll
            for (int bj = 0; bj < 2; ++bj) { const f32x4 b0 = *(const f32x4*)(bias + col0 + bj * 128), b1 = *(const f32x4*)(bias + col0 + bj * 128 + 4);
#pragma unroll
                for (int j = 0; j < 4; ++j) { bv[bj][j] = b0[j]; bv[bj][4 + j] = b1[j]; } }
        }
#pragma unroll
        EPI_ROWS(ai, m) { const size_t off = (size_t)(row0 + ai * 128 + m * 16) * ldc + col0; float sq = 0.f;
#pragma unroll
            for (int bj = 0; bj < 2; ++bj) {
                float v[8];
#pragma unroll
                for (int j = 0; j < 4; ++j) { v[j] = acc[ai][bj][m][0][j]; v[4 + j] = acc[ai][bj][m][1][j]; }
                if (MODE == EM_GLU) { float x[8]; unpack8(*(const u32x4*)(X1 + off + bj * 128), x);
#pragma unroll
                    for (int j = 0; j < 8; ++j) v[j] = x[j] * fsigmoid(v[j] + bv[bj][j]); }
                if (MODE == EM_GATE) { float x[8]; unpack8(*(const u32x4*)(X1 + off + bj * 128), x);
#pragma unroll
                    for (int j = 0; j < 8; ++j) v[j] = x[j] * v[j]; }
                if (MODE == EM_GATEADD) { float x[8], t[8]; unpack8(*(const u32x4*)(X1 + off + bj * 128), x); unpack8(*(const u32x4*)(X2 + off + bj * 128), t);
#pragma unroll
                    for (int j = 0; j < 8; ++j) v[j] = t[j] + x[j] * v[j]; }
                if (MODE == EM_RELU2) { const float rs = bias[row0 + ai * 128 + m * 16];
#pragma unroll
                    for (int j = 0; j < 8; ++j) { const float r = fmaxf(v[j], 0.f) * rs; v[j] = r * r; } }
                if (MODE == EM_MULSIG) { float x[8]; unpack8(*(const u32x4*)(X1 + off + bj * 128), x);
#pragma unroll
                    for (int j = 0; j < 8; ++j) v[j] = x[j] * fsigmoid(v[j]); }
                if (ROWSQ) {
#pragma unroll
                    for (int j = 0; j < 8; ++j) sq += v[j] * v[j]; }
                u32x4 w; w.x = pk_bf16(v[0], v[1]); w.y = pk_bf16(v[2], v[3]); w.z = pk_bf16(v[4], v[5]); w.w = pk_bf16(v[6], v[7]);
#if defined(MK_NT)
                if (MODE == EM_RELU2 || MK_NT >= 2) __builtin_nontemporal_store(w, (u32x4*)(O + off + bj * 128)); else
#endif
                *(u32x4*)(O + off + bj * 128) = w;
            }
            if (ROWSQ) { sq += __shfl_xor(sq, 16); sq += __shfl_xor(sq, 32);
                if (fq == 0) rsq[(size_t)(row0 + ai * 128 + m * 16) * 16 + u.pn * 4 + wc] = sq; }
            if (m & 1) asm volatile("" ::: "memory");
        }
    }
};

template <int VARIANT>
struct EpiProbe {
    static constexpr bool PERM = true;
    bf16_t* scratch;
    __device__ __forceinline__ void operator()(AccRef acc, const pg8::Unit& u, int wr, int wc, int fr, int fq) const {
#pragma unroll
        EPI_ROWS(ai, m)
#pragma unroll
            for (int bj = 0; bj < 2; ++bj) {
                if (VARIANT == 0) asm volatile("" :: "v"(acc[ai][bj][m][0]), "v"(acc[ai][bj][m][1]));
                if (VARIANT == 1) { f32x4 a = acc[ai][bj][m][0], c = acc[ai][bj][m][1];
#pragma unroll
                    for (int j = 0; j < 4; ++j) { const float r0 = fmaxf(a[j], 0.f) * 1.01f, r1 = fmaxf(c[j], 0.f) * 1.01f; a[j] = r0 * r0; c[j] = r1 * r1; }
                    const u32x4 w = pack8(a, c); asm volatile("" :: "v"(w)); }
                if (VARIANT == 2) { const u32x4 w = pack8(acc[ai][bj][m][0], acc[ai][bj][m][1]);
                    bf16_t* sp = scratch + (size_t)blockIdx.x * 65536 + (wr * 64 + fr) * 256 + wc * 32 + 8 * fq;
                    *(u32x4*)(sp + (ai * 128 + m * 16) * 256 + bj * 128) = w; if (bj) asm volatile("" ::: "memory"); }
            }
    }
};
struct Params { const float* in[25]; float* out; unsigned char* ws; int ph_lo, ph_hi; };
constexpr int LDS_PARAM_OFF = 131072;
struct PArg {
    const LAS unsigned* b;
    __device__ __forceinline__ unsigned long long q(int i) const { const unsigned lo = __builtin_amdgcn_readfirstlane(b[2 * i]), hi = __builtin_amdgcn_readfirstlane(b[2 * i + 1]); return ((unsigned long long)hi << 32) | lo; }
    __device__ __forceinline__ const float* in(int i) const { return (const float*)(const __attribute__((address_space(1))) float*)q(i); }
    __device__ __forceinline__ float* out() const { return (float*)(__attribute__((address_space(1))) float*)q(25); }
    __device__ __forceinline__ unsigned char* ws() const { return (unsigned char*)(__attribute__((address_space(1))) unsigned char*)q(26); }
};
constexpr int NWAVES = 8, NTHR = 512;
constexpr int LDS_BYTES = 131072 + 4096;
enum { I_X = 0, I_P, I_GPRE, I_WIN, I_LRE, I_LIM, I_LDT, I_BRE, I_BIM, I_CRE, I_CIM, I_DSK, I_WGLU, I_BGLU, I_WA, I_WB, I_WOUT, I_GPOSTMIX, I_GPREMLP, I_W1, I_W2, I_GPOSTMLP, I_WPLE, I_WPG, I_GPLE };

__device__ __forceinline__ void transpose_item(const float* W, const float* gain, int K, int N, bf16_t* WT, LAS float* scr, int item, int lane) {
    const int nblk = N / 32, kb = item / nblk, nb = item % nblk, k0 = 64 * kb, n0 = 32 * nb;
#pragma unroll 8
    for (int i = 0; i < 32; ++i) { const int kk = 2 * i + (lane >> 5); scr[kk * 33 + (lane & 31)] = W[(size_t)(k0 + kk) * N + n0 + (lane & 31)] * (gain ? gain[k0 + kk] : 1.0f); }
    asm volatile("s_waitcnt lgkmcnt(0)" ::: "memory");
    const int c = lane & 7;
#pragma unroll
    for (int j = 0; j < 4; ++j) { const int n = (lane >> 3) + 8 * j; const LAS float* s = scr + (8 * c) * 33 + n;
        u32x4 o; o.x = pk_bf16(s[0 * 33], s[1 * 33]); o.y = pk_bf16(s[2 * 33], s[3 * 33]); o.z = pk_bf16(s[4 * 33], s[5 * 33]); o.w = pk_bf16(s[6 * 33], s[7 * 33]);
        *(u32x4*)(WT + (size_t)(n0 + n) * K + k0 + 8 * c) = o; }
    asm volatile("s_waitcnt lgkmcnt(0)" ::: "memory");
}

__device__ __forceinline__ void ssm_weights_job(PArg P, LAS unsigned char* lds, int job) {
    const int tid = threadIdx.x, g = job >> 4, c = job & 15;
    LAS double* zr = (LAS double*)lds;
    LAS double* zi = zr + 64;
    LAS double* cfr = zi + 64;
    LAS double* cfi = cfr + 64;
    LAS float* apw = (LAS float*)(cfi + 64);
    LAS float* bb = apw + 33 * 64 * 2;
    LAS float* cc = bb + 64 * 16 * 2;
    LAS float* kt = cc + 128;
    const float* lre = P.in(I_LRE); const float* lim = P.in(I_LIM); const float* ldt = P.in(I_LDT);
    if (tid < 64) {
        const int p = tid; const double lr = lre[g * 64 + p], li = lim[g * 64 + p], dt = exp((double)ldt[g]);
        const double a = lr * dt, b = li * dt, er = exp(a), ar = er * cos(b), ai = er * sin(b);
        const double nr = ar - 1.0, ni = ai, den = lr * lr + li * li;
        zr[p] = a; zi[p] = b; cfr[p] = (nr * lr + ni * li) / den; cfi[p] = (ni * lr - nr * li) / den;
    }
    __syncthreads();
    for (int e = tid; e < 33 * 64; e += NTHR) { const int tau = e >> 6, p = e & 63; const double er = exp(zr[p] * tau), an = zi[p] * tau; apw[2 * e] = (float)(er * cos(an)); apw[2 * e + 1] = (float)(er * sin(an)); }
    for (int e = tid; e < 64 * 16; e += NTHR) { const int p = e >> 4; const double br = P.in(I_BRE)[(size_t)(g * 64) * 16 + e], bi = P.in(I_BIM)[(size_t)(g * 64) * 16 + e];
        bb[2 * e] = (float)(cfr[p] * br - cfi[p] * bi); bb[2 * e + 1] = (float)(cfr[p] * bi + cfi[p] * br); }
    if (tid < 64) { cc[2 * tid] = P.in(I_CRE)[(size_t)(g * 16 + c) * 64 + tid]; cc[2 * tid + 1] = P.in(I_CIM)[(size_t)(g * 16 + c) * 64 + tid]; }
    __syncthreads();
    {
        const int tau = tid >> 4, cp = tid & 15; float s = 0.f;
        for (int p = 0; p < 64; ++p) { const float cr = cc[2 * p], ci = cc[2 * p + 1], ar = apw[2 * (tau * 64 + p)], ai = apw[2 * (tau * 64 + p) + 1];
            const float pr = cr * ar - ci * ai, pi = cr * ai + ci * ar; s += pr * bb[2 * (p * 16 + cp)] - pi * bb[2 * (p * 16 + cp) + 1]; }
        kt[tid] = s;
    }
    __syncthreads();
    bf16_t* W2 = (bf16_t*)(P.ws() + WS_WS2) + (size_t)g * 512 * APK;
    for (int e = tid; e < 32 * (APK / 2); e += NTHR) {
        const int i = e / (APK / 2), k = 2 * (e % (APK / 2)); float v[2];
#pragma unroll
        for (int d = 0; d < 2; ++d) { const int kk = k + d;
            if (kk < 128) { const int ri = kk >> 6, p = kk & 63; const float cr = cc[2 * p], ci = cc[2 * p + 1], ar = apw[2 * ((i + 1) * 64 + p)], ai = apw[2 * ((i + 1) * 64 + p) + 1];
                v[d] = ri == 0 ? (cr * ar - ci * ai) : -(cr * ai + ci * ar); }
            else { const int ip = (kk - 128) >> 4, cp = kk & 15, tau = i - ip; v[d] = tau >= 0 ? kt[tau * 16 + cp] : 0.f; } }
        *(unsigned*)(W2 + (size_t)(i * 16 + c) * APK + k) = pk_bf16(v[0], v[1]);
    }
    bf16_t* W1 = (bf16_t*)(P.ws() + WS_WS1) + (size_t)g * 256 * 512;
    for (int e = tid; e < 16 * 256; e += NTHR) {
        const int r = c * 16 + (e >> 8), k = 2 * (e & 255); float v[2] = {0.f, 0.f};
        if (r < 128) { const int ri = r >> 6, p = r & 63;
#pragma unroll
            for (int d = 0; d < 2; ++d) { const int kk = k + d, ip = kk >> 4, cp = kk & 15; const float ar = apw[2 * ((31 - ip) * 64 + p)], ai = apw[2 * ((31 - ip) * 64 + p) + 1], br = bb[2 * (p * 16 + cp)], bi = bb[2 * (p * 16 + cp) + 1];
                v[d] = ri == 0 ? (ar * br - ai * bi) : (ar * bi + ai * br); } }
        *(unsigned*)(W1 + (size_t)r * 512 + k) = pk_bf16(v[0], v[1]);
    }
    if (c == 0 && tid < 64) { float* al = (float*)(P.ws() + WS_AL) + (size_t)(g * 64 + tid) * 2; al[0] = apw[2 * (32 * 64 + tid)]; al[1] = apw[2 * (32 * 64 + tid) + 1]; }
    __syncthreads();
}

__device__ __forceinline__ void phase_prep(PArg P, LAS unsigned char* lds) {
    const int tid = threadIdx.x, lane = tid & 63, wave = __builtin_amdgcn_readfirstlane(tid >> 6), G = gridDim.x;
    unsigned char* ws = P.ws();
    for (int job = blockIdx.x; job < NG * GC; job += G) ssm_weights_job(P, lds, job);
    LAS float* scr = (LAS float*)(lds + wave * 16384);
    const int gw = blockIdx.x * NWAVES + wave, NGW = G * NWAVES;
    struct TJ { int idx, K, N; size_t off; int gi; };
    const TJ tj[9] = {{I_WIN, 1024, 4096, WS_WIN, I_GPRE}, {I_W1, 1024, 4096, WS_W1, I_GPREMLP}, {I_W2, 4096, 1024, WS_W2, -1}, {I_WOUT, 1024, 1024, WS_WOUT, -1}, {I_WPG, 1024, 1024, WS_WPG, -1},
                      {I_WA, 512, 1024, WS_WA, -1}, {I_WB, 512, 1024, WS_WB, -1}, {I_WGLU, 512, 512, WS_WGLU, -1}, {I_WPLE, 256, 1024, WS_WPLE, -1}};
    int base = 0;
#pragma unroll
    for (int j = 0; j < 9; ++j) { const int items = (tj[j].K / 64) * (tj[j].N / 32);
        const float* gain = tj[j].gi >= 0 ? P.in(tj[j].gi) : nullptr;
        for (int it = gw; it < items; it += NGW) transpose_item(P.in(tj[j].idx), gain, tj[j].K, tj[j].N, (bf16_t*)(ws + tj[j].off), scr, it, lane);
        base += items; }
    (void)base;
}

namespace att {
constexpr int L_K = 0, L_V = 16384, L_KM = 32768, L_WS = 36864, L_OST = 38912, L_END = L_OST + 8 * 4096;
#ifndef MK_THR
#define MK_THR 8.0f
#endif
constexpr float NEG = -1e30f, THR = MK_THR;
__device__ __forceinline__ int crow(int r, int hi) { return (r & 3) + 8 * (r >> 2) + 4 * hi; }
__device__ __forceinline__ s16x4 vtr(const LAS unsigned char* p) { typedef short v4i16_t __attribute__((ext_vector_type(4))); return __builtin_bit_cast(s16x4, __builtin_amdgcn_ds_read_tr16_b64_v4i16((LAS v4i16_t*)p)); }

template <int AV>
__device__ __forceinline__ void attn_phase(PArg P, LAS unsigned char* lds) {
    const int tid = threadIdx.x, lane = tid & 63, wid = __builtin_amdgcn_readfirstlane(tid >> 6), r32 = lane & 31, hi = lane >> 5;
    const bf16_t* Q = (const bf16_t*)(P.ws() + WS_Q); const bf16_t* Kb = (const bf16_t*)(P.ws() + WS_K); const bf16_t* Vb = (const bf16_t*)(P.ws() + WS_V);
    const float* kmean = (const float*)(P.ws() + WS_KMEAN); bf16_t* O = (bf16_t*)(P.ws() + WS_ATT);
    LAS float* wsf = (LAS float*)(lds + L_WS) + wid * 64;
    const int srow = tid >> 3, sch = tid & 7;
    const int kst = srow * 128 + ((sch ^ ((srow >> 1) & 7)) << 4), vst = srow * 128 + ((sch ^ (((srow >> 1) & 1) << 2)) << 4);
    const int kswz = (r32 >> 1) & 7;
    int kfo[4];
#pragma unroll
    for (int ks = 0; ks < 4; ++ks) kfo[ks] = r32 * 128 + (((2 * ks + hi) ^ kswz) << 4);
    const int q4 = (lane & 15) >> 2, p4 = lane & 3, blk = (lane >> 4) & 1, vswz = ((q4 >> 1) & 1) << 2, cl = 2 * blk + (p4 >> 1);
    const int vrow = (4 * hi + q4) * 128 + 8 * (p4 & 1);
    const int vo0 = vrow + ((vswz + cl) << 4), vo1 = vrow + (((4 ^ vswz) + cl) << 4);
    for (int bh = blockIdx.x; bh < BATCH * NHEAD; bh += gridDim.x) {
        const int b = bh >> 3, h = bh & 7;
        __syncthreads();
        if (tid < 256) {
            const int row = tid >> 3, ch = tid & 7; u32x4 w = (u32x4){0u, 0u, 0u, 0u};
            if (row < 16) { const float* km = kmean + (size_t)(b * NBLK + (row & 7)) * ATT_W + h * HD + ch * 8; float v[8];
#pragma unroll
                for (int j = 0; j < 8; ++j) { const float x = km[j] + km[(size_t)NM_PANELS * 512 + j], xh = bf_round(x); v[j] = (row < 8) ? xh : (x - xh); }
                w.x = pk_bf16(v[0], v[1]); w.y = pk_bf16(v[2], v[3]); w.z = pk_bf16(v[4], v[5]); w.w = pk_bf16(v[6], v[7]); }
            *(LAS u32x4*)(lds + L_KM + row * 128 + ((ch ^ ((row >> 1) & 7)) << 4)) = w;
        }
        __syncthreads();
        const bf16_t* Kh = Kb + (size_t)b * SEQ * ATT_W + h * HD; const bf16_t* Vh = Vb + (size_t)b * SEQ * ATT_W + h * HD;
        for (int jb = 0; jb < NBLK; ++jb) {
            const int q0 = jb * MBLK + wid * 32;
            const bf16_t* Qrow = Q + ((size_t)(b * SEQ + q0 + r32)) * ATT_W + h * HD;
            bf16x8 qr[4];
#pragma unroll
            for (int ks = 0; ks < 4; ++ks) qr[ks] = *(const bf16x8*)(Qrow + 16 * ks + 8 * hi);
            unsigned sel = 0;
            {
                f32x16 gz;
#pragma unroll
                for (int r = 0; r < 16; ++r) gz[r] = 0.f;
#pragma unroll
                for (int ks = 0; ks < 4; ++ks) { const bf16x8 kf = *(const LAS bf16x8*)(lds + L_KM + kfo[ks]); gz = __builtin_amdgcn_mfma_f32_32x32x16_bf16(kf, qr[ks], gz, 0, 0, 0); }
                float gate[8];
#pragma unroll
                for (int r = 0; r < 4; ++r) { const float mine = gz[r] + gz[r + 4], oth = __shfl_xor(mine, 32); gate[r] = hi ? oth : mine; gate[r + 4] = hi ? mine : oth; }
#pragma unroll
                for (int it = 0; it < 3; ++it) { int best = -1; float bv = 0.f;
#pragma unroll
                    for (int n = 0; n < 8; ++n) { const bool ok = (n < jb) && !((sel >> n) & 1u); if (ok && (best < 0 || gate[n] > bv)) { best = n; bv = gate[n]; } }
                    if (best >= 0) sel |= 1u << best; }
            }
            const int NT = 4 * (jb + 1);
            float mref, lsum, cbias; bool started;
            f32x16 o0, o1, biasv;
            bool robust = false;
            for (;;) {
            mref = 0.f; lsum = 0.f; cbias = 0.f; started = false;
#pragma unroll
            for (int r = 0; r < 16; ++r) { o0[r] = 0.f; o1[r] = 0.f; biasv[r] = 0.f; }
            u32x4 kA, vA, kB, vB;
#define ATT_LD(kr, vr, tt) do { kr = *(const u32x4*)(Kh + (size_t)((tt) * 64 + srow) * ATT_W + sch * 8); vr = *(const u32x4*)(Vh + (size_t)((tt) * 64 + srow) * ATT_W + sch * 8); } while (0)
#define ATT_ST(kr, vr, bufo) do { *(LAS u32x4*)(lds + L_K + (bufo) + kst) = kr; *(LAS u32x4*)(lds + L_V + (bufo) + vst) = vr; } while (0)
            ATT_LD(kA, vA, 0); ATT_LD(kB, vB, 1);
            ATT_ST(kA, vA, 0);
            __syncthreads();
#define ATT_TILE(t, buf) do { \
                const int nb = (t) >> 2, to = (t) & 3; const bool own = (nb == jb); \
                const bool lane_sel = own || ((sel >> nb) & 1u); \
                const bool active = own ? (to <= (wid >> 1)) : (__any(lane_sel) != 0); \
                if (active) { \
                    const float bias = lane_sel ? -mref : NEG; \
                    if (__any(bias != cbias)) { cbias = bias; _Pragma("unroll") for (int r = 0; r < 16; ++r) biasv[r] = bias; } \
                    f32x16 p0, p1; \
                    const LAS unsigned char* kb_ = lds + L_K + (buf); \
                    if (AV == 4) { p0 = biasv; p1 = biasv; asm volatile("" : "+v"(p0), "+v"(p1)); } else { \
                    { const bf16x8 k0 = *(const LAS bf16x8*)(kb_ + kfo[0]), k1 = *(const LAS bf16x8*)(kb_ + 4096 + kfo[0]); \
                      p0 = __builtin_amdgcn_mfma_f32_32x32x16_bf16(k0, qr[0], biasv, 0, 0, 0); p1 = __builtin_amdgcn_mfma_f32_32x32x16_bf16(k1, qr[0], biasv, 0, 0, 0); } \
                    _Pragma("unroll") for (int ks = 1; ks < 4; ++ks) { \
                        const bf16x8 k0 = *(const LAS bf16x8*)(kb_ + kfo[ks]), k1 = *(const LAS bf16x8*)(kb_ + 4096 + kfo[ks]); \
                        p0 = __builtin_amdgcn_mfma_f32_32x32x16_bf16(k0, qr[ks], p0, 0, 0, 0); p1 = __builtin_amdgcn_mfma_f32_32x32x16_bf16(k1, qr[ks], p1, 0, 0, 0); } } \
                      \
                    const LAS unsigned char* vb_ = lds + L_V + (buf); \
                    bf16x8 vfa[4], vfb[4]; \
                    if (AV != 2) { _Pragma("unroll") for (int kk = 0; kk < 4; ++kk) { \
                        const int ro = (32 * (kk >> 1) + 16 * (kk & 1)) * 128; \
                        const s16x4 a0 = vtr(vb_ + ro + vo0), a1 = vtr(vb_ + ro + 8 * 128 + vo0); \
                        const s16x4 c0 = vtr(vb_ + ro + vo1), c1 = vtr(vb_ + ro + 8 * 128 + vo1); \
                        vfa[kk] = __builtin_shufflevector(a0, a1, 0, 1, 2, 3, 4, 5, 6, 7); vfb[kk] = __builtin_shufflevector(c0, c1, 0, 1, 2, 3, 4, 5, 6, 7); } } \
                    if (own && to == (wid >> 1)) { const int ql = (wid & 1) * 32 + r32; \
                        _Pragma("unroll") for (int r = 0; r < 16; ++r) { const int kl = crow(r, hi); if (kl > ql) p0[r] = NEG; if (kl + 32 > ql) p1[r] = NEG; } } \
                    if (robust) { \
                    float mx = fmaxf(p0[0], p1[0]); \
                    _Pragma("unroll") for (int r = 1; r < 16; ++r) mx = fmaxf(fmaxf(mx, p0[r]), p1[r]); \
                    mx = fmaxf(mx, __shfl_xor(mx, 32)); \
                    const bool valid = mx > -1e29f; \
                    const bool need = valid && (!started || mx > THR); \
                    if (__any(need)) { \
                        const float dl = need ? mx : 0.f; \
                        const float f = (need && started) ? __builtin_amdgcn_exp2f(-dl) : 1.0f; \
                        mref += dl; lsum *= f; \
                        _Pragma("unroll") for (int r = 0; r < 16; ++r) { p0[r] -= dl; p1[r] -= dl; } \
                        if (hi == 0) wsf[r32] = f; \
                        asm volatile("s_waitcnt lgkmcnt(0)" ::: "memory"); \
                        _Pragma("unroll") for (int r = 0; r < 16; ++r) { const float fr_ = wsf[crow(r, hi)]; o0[r] *= fr_; o1[r] *= fr_; } \
                    } \
                    started = started || valid; } \
                    float ls = 0.f; \
                    if (AV != 1) { _Pragma("unroll") for (int r = 0; r < 16; ++r) { p0[r] = __builtin_amdgcn_exp2f(p0[r]); p1[r] = __builtin_amdgcn_exp2f(p1[r]); ls += p0[r] + p1[r]; } } \
                    lsum += ls; \
                    bf16x8 pa[4]; \
                    _Pragma("unroll") for (int s2 = 0; s2 < 2; ++s2) { u32x4 w0, w1; \
                        w0.x = pk_bf16(p0[8 * s2 + 0], p0[8 * s2 + 1]); w0.y = pk_bf16(p0[8 * s2 + 2], p0[8 * s2 + 3]); w0.z = pk_bf16(p0[8 * s2 + 4], p0[8 * s2 + 5]); w0.w = pk_bf16(p0[8 * s2 + 6], p0[8 * s2 + 7]); \
                        w1.x = pk_bf16(p1[8 * s2 + 0], p1[8 * s2 + 1]); w1.y = pk_bf16(p1[8 * s2 + 2], p1[8 * s2 + 3]); w1.z = pk_bf16(p1[8 * s2 + 4], p1[8 * s2 + 5]); w1.w = pk_bf16(p1[8 * s2 + 6], p1[8 * s2 + 7]); \
                        pa[s2] = __builtin_bit_cast(bf16x8, w0); pa[2 + s2] = __builtin_bit_cast(bf16x8, w1); } \
                    if (AV == 2) { asm volatile("" :: "v"(pa[0]), "v"(pa[1]), "v"(pa[2]), "v"(pa[3])); } else \
                    _Pragma("unroll") for (int kk = 0; kk < 4; ++kk) { \
                        o0 = __builtin_amdgcn_mfma_f32_32x32x16_bf16(pa[kk], vfa[kk], o0, 0, 0, 0); \
                        o1 = __builtin_amdgcn_mfma_f32_32x32x16_bf16(pa[kk], vfb[kk], o1, 0, 0, 0); } \
                } } while (0)
            for (int t = 0; t < NT; t += 2) {
                if (AV != 3) { if (t + 2 < NT) ATT_LD(kA, vA, t + 2); }
                ATT_TILE(t, 0);
                if (AV != 3) { ATT_ST(kB, vB, 8192);
                __syncthreads();
                if (t + 3 < NT) ATT_LD(kB, vB, t + 3); }
                ATT_TILE(t + 1, 8192);
                if (AV != 3) { if (t + 2 < NT) ATT_ST(kA, vA, 0);
                __syncthreads(); }
            }
            lsum += __shfl_xor(lsum, 32);
            if (robust || AV != 0) break;
            {
#if defined(MK_FORCE_ROBUST)
                const bool bad = true;
#else
                const bool bad = !(lsum > 1e-30f && lsum < 1e30f);
#endif
                LAS unsigned* fl = (LAS unsigned*)(lds + L_END);
                const unsigned wb = __any(bad) ? 1u : 0u;
                if (lane == 0) fl[wid] = wb;
                __syncthreads();
                unsigned anyb = 0;
#pragma unroll
                for (int w8 = 0; w8 < 8; ++w8) anyb |= fl[w8];
                __syncthreads();
                if (!anyb) break;
                robust = true;
            }
            }
#undef ATT_LD
#undef ATT_ST
#undef ATT_TILE
            if (hi == 0) wsf[32 + r32] = lsum;
            asm volatile("s_waitcnt lgkmcnt(0)" ::: "memory");
            LAS bf16_t* stg = (LAS bf16_t*)(lds + L_OST) + wid * 2048;
#pragma unroll
            for (int r = 0; r < 16; ++r) { const int orow = crow(r, hi); const float rl = __builtin_amdgcn_rcpf(wsf[32 + orow]);
                stg[orow * 64 + r32] = (bf16_t)(pk_bf16(o0[r] * rl, 0.f) & 0xffffu); stg[orow * 64 + 32 + r32] = (bf16_t)(pk_bf16(o1[r] * rl, 0.f) & 0xffffu); }
            asm volatile("s_waitcnt lgkmcnt(0)" ::: "memory");
            if (AV != 0) { asm volatile("" :: "v"(o0), "v"(o1), "v"(lsum)); continue; }
            bf16_t* Ow = O + ((size_t)(b * SEQ + q0)) * ATT_W + h * HD;
#pragma unroll
            for (int i = 0; i < 4; ++i) { const int row = i * 8 + (lane >> 3), ch = lane & 7; const u32x4 v = *(const LAS u32x4*)(stg + row * 64 + ch * 8); *(u32x4*)(Ow + (size_t)row * ATT_W + ch * 8) = v; }
        }
    }
}
}


#ifndef MK_ATT2
#define MK_ATT2 1
#endif
#ifndef MK_THRL
#define MK_THRL 8
#endif
namespace att2 {
constexpr int NSLOT = 3, SLOTB = 8192;
constexpr int L_K = 0, L_V = NSLOT * SLOTB, L_WS = 2 * NSLOT * SLOTB, L_OST = L_WS + 8 * 64 * 4, L_KM = L_OST + 8 * 4096, L_END = L_KM + 4096;
constexpr float NEGB = -1e30f;
__device__ __forceinline__ int crow(int r, int hi) { return (r & 3) + 8 * (r >> 2) + 4 * hi; }
#define SBAR() __builtin_amdgcn_sched_barrier(0)
#define WAIT_BAR(N) asm volatile("s_waitcnt vmcnt(" #N ") lgkmcnt(0)\n\ts_barrier" ::: "memory")
__device__ __forceinline__ void glds16(const void* gsrc, unsigned lds_dst) { unsigned keep;
    asm volatile("s_mov_b32 %0, m0\n\ts_mov_b32 m0, %2\n\ts_nop 0\n\tglobal_load_lds_dwordx4 %1, off\n\ts_mov_b32 m0, %0" : "=&s"(keep) : "v"(gsrc), "s"(lds_dst) : "memory"); }
__device__ __forceinline__ float max3f(float a, float b, float c) { float r; asm("v_max3_f32 %0, %1, %2, %3" : "=v"(r) : "v"(a), "v"(b), "v"(c)); return r; }
__device__ __forceinline__ float max2f(float a, float b) { float r; asm("v_max_f32_e32 %0, %1, %2" : "=v"(r) : "v"(a), "v"(b)); return r; }
__device__ __forceinline__ float fadd_s(float a, float b) { float r; asm("v_add_f32_e32 %0, %1, %2" : "=v"(r) : "v"(a), "v"(b)); return r; }
__device__ __forceinline__ float fsub_s(float a, float b) { float r; asm("v_sub_f32_e32 %0, %1, %2" : "=v"(r) : "v"(a), "v"(b)); return r; }
__device__ __forceinline__ unsigned cvtpk_s(float lo, float hi) { f32x2_t v = {lo, hi}; bf16x2_t b = __builtin_convertvector(v, bf16x2_t); return __builtin_bit_cast(unsigned, b); }
typedef const LAS unsigned char* lds_cptr;
typedef short v4i16_t __attribute__((ext_vector_type(4)));
__device__ __forceinline__ void cmask(f32x16& p0, f32x16& p1, int jb, int qrel, int hi) {
    const float NEG = -INFINITY; const int kb = 64 * jb + 4 * hi;
#pragma unroll
    for (int r = 0; r < 16; ++r) { const int kv = kb + (r & 3) + 8 * (r >> 2); if (kv > qrel) p0[r] = NEG; if (kv + 32 > qrel) p1[r] = NEG; }
}
__device__ __forceinline__ void qkt(f32x16& p0, f32x16& p1, lds_cptr kb, const bf16x8* qr, const f32x16& negm) {
#pragma unroll
    for (int d0 = 0; d0 < 4; ++d0) {
        const bf16x8 b0 = *(const LAS bf16x8*)(kb + d0 * 2048);
        const bf16x8 b1 = *(const LAS bf16x8*)(kb + d0 * 2048 + 512);
        if (d0 == 0) { p0 = __builtin_amdgcn_mfma_f32_32x32x16_bf16(b0, qr[0], negm, 0, 0, 0); p1 = __builtin_amdgcn_mfma_f32_32x32x16_bf16(b1, qr[0], negm, 0, 0, 0); }
        else { p0 = __builtin_amdgcn_mfma_f32_32x32x16_bf16(b0, qr[d0], p0, 0, 0, 0); p1 = __builtin_amdgcn_mfma_f32_32x32x16_bf16(b1, qr[d0], p1, 0, 0, 0); } }
}
__device__ __forceinline__ void kload8(bf16x8* kf, lds_cptr kp) {
    kf[0] = *(const LAS bf16x8*)(kp);        kf[1] = *(const LAS bf16x8*)(kp + 512);
    kf[2] = *(const LAS bf16x8*)(kp + 2048); kf[3] = *(const LAS bf16x8*)(kp + 2560);
    kf[4] = *(const LAS bf16x8*)(kp + 4096); kf[5] = *(const LAS bf16x8*)(kp + 4608);
    kf[6] = *(const LAS bf16x8*)(kp + 6144); kf[7] = *(const LAS bf16x8*)(kp + 6656);
}
__device__ __forceinline__ void kload2(bf16x8* kf, lds_cptr kp, int j) { kf[2 * j] = *(const LAS bf16x8*)(kp + j * 2048); kf[2 * j + 1] = *(const LAS bf16x8*)(kp + j * 2048 + 512); }
__device__ __forceinline__ s16x4 vtr(lds_cptr p) { return __builtin_bit_cast(s16x4, __builtin_amdgcn_ds_read_tr16_b64_v4i16((LAS v4i16_t*)p)); }
__device__ __forceinline__ float rowmax(const f32x16& p0, const f32x16& p1) {
    float a = max3f(p0[0], p0[1], p1[0]), b = max3f(p0[2], p0[3], p1[1]); a = max3f(a, p1[2], p1[3]);
#pragma unroll
    for (int r = 4; r < 16; r += 4) { a = max3f(a, p0[r], p0[r + 1]); b = max3f(b, p0[r + 2], p0[r + 3]); a = max3f(a, p1[r], p1[r + 1]); b = max3f(b, p1[r + 2], p1[r + 3]); }
    const float m = max2f(a, b);
    auto rr = __builtin_amdgcn_permlane32_swap(__float_as_uint(m), __float_as_uint(m), false, false);
    return max2f(__uint_as_float(rr[0]), __uint_as_float(rr[1]));
}
__device__ __forceinline__ void pv(f32x16* o, int vb, bf16x8 pa0, bf16x8 pa1, bf16x8 pa2, bf16x8 pa3) {
#pragma unroll
    for (int d0 = 0; d0 < 2; ++d0) { s16x4 lo[4], hi[4];
#pragma unroll
        for (int ks = 0; ks < 4; ++ks) {
            asm volatile("ds_read_b64_tr_b16 %0,%1 offset:%c2" : "=&v"(lo[ks]) : "v"(vb), "i"(d0 * 4096 + ks * 1024) : "memory");
            asm volatile("ds_read_b64_tr_b16 %0,%1 offset:%c2" : "=&v"(hi[ks]) : "v"(vb), "i"(d0 * 4096 + ks * 1024 + 512) : "memory"); }
        asm volatile("s_waitcnt lgkmcnt(0)" ::: "memory"); SBAR();
#define PK(k) (bf16x8){lo[k][0], lo[k][1], lo[k][2], lo[k][3], hi[k][0], hi[k][1], hi[k][2], hi[k][3]}
        o[d0] = __builtin_amdgcn_mfma_f32_32x32x16_bf16(pa0, PK(0), o[d0], 0, 0, 0);
        o[d0] = __builtin_amdgcn_mfma_f32_32x32x16_bf16(pa1, PK(1), o[d0], 0, 0, 0);
        o[d0] = __builtin_amdgcn_mfma_f32_32x32x16_bf16(pa2, PK(2), o[d0], 0, 0, 0);
        o[d0] = __builtin_amdgcn_mfma_f32_32x32x16_bf16(pa3, PK(3), o[d0], 0, 0, 0);
#undef PK
    }
}

template <int THRL, int PM>
__device__ __forceinline__ void attn_phase(PArg P, LAS unsigned char* lds) {
    const int tid = threadIdx.x; const int wid = __builtin_amdgcn_readfirstlane(tid >> 6);
    const bf16_t* Q = (const bf16_t*)(P.ws() + WS_Q); const bf16_t* Kb = (const bf16_t*)(P.ws() + WS_K); const bf16_t* Vb = (const bf16_t*)(P.ws() + WS_V);
    const float* kmean = (const float*)(P.ws() + WS_KMEAN); bf16_t* O = (bf16_t*)(P.ws() + WS_ATT);
    LAS float* wsf = (LAS float*)(lds + L_WS) + wid * 64;
    const unsigned lds0 = (unsigned)(uintptr_t)lds;
    const unsigned kdst = lds0 + L_K + wid * 1024, vdst = lds0 + L_V + wid * 1024;
    for (int bh = blockIdx.x; bh < BATCH * NHEAD; bh += gridDim.x) {
        const int b = bh >> 3, h = bh & 7;
        __syncthreads();
        if (tid < 256) {
            const int row = tid >> 3, ch = tid & 7; u32x4 w = (u32x4){0u, 0u, 0u, 0u};
            if (row < 16) { const float* km = kmean + (size_t)(b * NBLK + (row & 7)) * ATT_W + h * HD + ch * 8; float v[8];
#pragma unroll
                for (int j = 0; j < 8; ++j) { const float x = km[j] + km[(size_t)NM_PANELS * 512 + j], xh = bf_round(x); v[j] = (row < 8) ? xh : (x - xh); }
                w.x = pk_bf16(v[0], v[1]); w.y = pk_bf16(v[2], v[3]); w.z = pk_bf16(v[4], v[5]); w.w = pk_bf16(v[6], v[7]); }
            *(LAS u32x4*)(lds + L_KM + row * 128 + ((ch ^ ((row >> 1) & 7)) << 4)) = w;
        }
        __syncthreads();
        const int bk = (PM == 2) ? 0 : b, hk = (PM == 2) ? 0 : h;
        const bf16_t* Kh = Kb + (size_t)bk * SEQ * ATT_W + hk * HD; const bf16_t* Vh = Vb + (size_t)bk * SEQ * ATT_W + hk * HD;
#define DMA_K(t, slot) glds16(ksrc + (size_t)(t) * 64 * ATT_W, (unsigned)__builtin_amdgcn_readfirstlane(kdst + (slot)))
#define DMA_V(t, slot) glds16(vsrc + (size_t)(t) * 64 * ATT_W, (unsigned)__builtin_amdgcn_readfirstlane(vdst + (slot)))
#define NXT(x) (((x) == (NSLOT - 1) * SLOTB) ? 0 : (x) + SLOTB)
        int ring0 = 0;
        bf16x8 qr[4];
        {
            int tido = tid; asm volatile("" : "+v"(tido));
            const int lane = tido & 63, r32 = lane & 31, hi = lane >> 5;
            const bf16_t* ksrc = Kh + (size_t)lane * ATT_W + wid * 8;
            const bf16_t* vsrc = Vh + (size_t)(16 * (wid & 3) + (lane >> 2)) * ATT_W + (wid >> 2) * 32 + (lane & 3) * 8;
            const bf16_t* Qw = Q + ((size_t)(b * SEQ + wid * 32)) * ATT_W + h * HD;
            DMA_K(0, 0); DMA_V(0, 0); DMA_K(1, SLOTB);
#pragma unroll
            for (int d0 = 0; d0 < 4; ++d0) qr[d0] = *(const bf16x8*)(Qw + (size_t)r32 * ATT_W + d0 * 16 + hi * 8);
            DMA_K(2, 2 * SLOTB);
        }
        for (int jb = 0; jb < NBLK; ++jb) {
            int jbo = jb; asm volatile("" : "+s"(jbo));
            int tido = tid; asm volatile("" : "+v"(tido));
            const int lane = tido & 63, r32 = lane & 31, hi = lane >> 5;
            const int vb0 = (int)(lds0 + L_V) + ((lane >> 4) & 1) * 32 + (lane & 3) * 8 + (4 * hi + ((lane & 15) >> 2)) * 64;
            const lds_cptr kp0 = lds + L_K + hi * 1024 + r32 * 16;
            const lds_cptr vp0 = lds + L_V + ((lane >> 4) & 1) * 32 + (lane & 3) * 8 + (4 * hi + ((lane & 15) >> 2)) * 64;
            const int qrel = wid * 32 + r32;
            const bf16_t* ksrc = Kh + (size_t)lane * ATT_W + wid * 8;
            const bf16_t* vsrc = Vh + (size_t)(16 * (wid & 3) + (lane >> 2)) * ATT_W + (wid >> 2) * 32 + (lane & 3) * 8;
            const int q0 = jbo * MBLK;
            const bf16_t* Qw = Q + ((size_t)(b * SEQ + q0 + wid * 32)) * ATT_W + h * HD;
            const int NT = (PM == 1) ? 4 : 4 * (jbo + 1);
            unsigned sel = 0;
            {
                const int kswz = (r32 >> 1) & 7;
                f32x16 gz;
#pragma unroll
                for (int r = 0; r < 16; ++r) gz[r] = 0.f;
#pragma unroll
                for (int ks = 0; ks < 4; ++ks) { const bf16x8 kf_ = *(const LAS bf16x8*)(lds + L_KM + r32 * 128 + (((2 * ks + hi) ^ kswz) << 4)); gz = __builtin_amdgcn_mfma_f32_32x32x16_bf16(kf_, qr[ks], gz, 0, 0, 0); }
                float gate[8];
#pragma unroll
                for (int r = 0; r < 4; ++r) { const float mine = gz[r] + gz[r + 4], oth = __shfl_xor(mine, 32); gate[r] = hi ? oth : mine; gate[r + 4] = hi ? mine : oth; }
#pragma unroll
                for (int it = 0; it < 3; ++it) { int best = -1; float bv = 0.f;
#pragma unroll
                    for (int n = 0; n < 8; ++n) { const bool ok = (n < jbo) && !((sel >> n) & 1u); if (ok && (best < 0 || gate[n] > bv)) { best = n; bv = gate[n]; } }
                    if (best >= 0) sel |= 1u << best; }
                sel |= (PM == 1) ? 1u : (1u << jbo);
            }
            bf16x8 kf[8];
            float mhat = 0.f, l_reg = 0.f; f32x16 o[2]; f32x16 negm; bool started = false;
#pragma unroll
            for (int r = 0; r < 16; ++r) { o[0][r] = 0.f; o[1][r] = 0.f; }
            { const float nb_ = (sel & 1u) ? 0.f : NEGB;
#pragma unroll
              for (int r = 0; r < 16; ++r) negm[r] = nb_; }
            asm volatile("" : "+v"(negm));
#define CMASK(P0, P1, t) do { int jb_ = (t) - (NT - 4); if (jb_ >= 0) cmask(P0, P1, jb_, qrel, hi); } while (0)
#define SETNEGM(tn) do { const float nb_ = ((sel >> ((tn) >> 2)) & 1u) ? -mhat : NEGB; _Pragma("unroll") for (int r = 0; r < 16; ++r) negm[r] = nb_; asm volatile("" : "+v"(negm)); } while (0)
            bool resc = false;
#define START(P0, P1) do { const float rm = rowmax(P0, P1); resc = false; \
                { const bool valid_ = rm > -1e29f; const float dl = valid_ ? rm : 0.f; started = valid_; mhat = fadd_s(mhat, dl); \
                  _Pragma("unroll") for (int r = 0; r < 16; ++r) { P0[r] = fsub_s(P0[r], dl); P1[r] = fsub_s(P1[r], dl); } \
                  SETNEGM(1); } \
                _Pragma("unroll") for (int r = 0; r < 16; ++r) P0[r] = __builtin_amdgcn_exp2f(P0[r]); } while (0)
#define RESC() do { if (resc) { asm volatile("s_waitcnt lgkmcnt(0)" ::: "memory"); \
                _Pragma("unroll") for (int d_ = 0; d_ < 2; ++d_) _Pragma("unroll") for (int r = 0; r < 16; ++r) o[d_][r] *= wsf[crow(r, hi)]; } } while (0)
            f32x16 pA0, pA1, pB0, pB1;
            int sl_prev = ring0, sl_cur = ring0, sl_next = NXT(ring0);
#define ROT() do { sl_prev = sl_cur; sl_cur = sl_next; sl_next = NXT(sl_next); } while (0)
            WAIT_BAR(3);
            qkt(pA0, pA1, kp0 + sl_cur, qr, negm); asm volatile("s_nop 15\n\ts_nop 7" : "+v"(pA0), "+v"(pA1)); CMASK(pA0, pA1, 0);
            START(pA0, pA1);
#pragma unroll
            for (int r = 0; r < 16; ++r) pA1[r] = __builtin_amdgcn_exp2f(pA1[r]);
            WAIT_BAR(0);
            DMA_K(3, sl_cur); DMA_V(1, sl_next);
            ROT();
            kload8(kf, kp0 + sl_cur);
            WAIT_BAR(2);
            s16x4 vlo[8], vhi[8]; u32x4 pw0, pw1, pw2, pw3;
#define PKW(P, B) cvtpk_s(P[B], P[B + 1])
#define PAF(k) __builtin_bit_cast(bf16x8, pw##k)
#define VFR(i) (bf16x8){vlo[i][0], vlo[i][1], vlo[i][2], vlo[i][3], vhi[i][0], vhi[i][1], vhi[i][2], vhi[i][3]}
#define PIN(x) asm volatile("" : "+v"(x))
#define MX3(a, b, c) __builtin_fmaxf(__builtin_fmaxf((a), (b)), (c))
#define GAPA(MF, A0, A1, A2, A3, W0, W1, PW) do { MF; sacc += A0; sacc += A1; sacc += A2; sacc += A3; PIN(sacc); W0; W1; PIN(PW); SBAR(); } while (0)
#define EX(v) __builtin_amdgcn_exp2f(v)
#define GAPB(MF, X, B) do { MF; X[B] = EX(X[B]); X[B + 1] = EX(X[B + 1]); X[B + 2] = EX(X[B + 2]); X[B + 3] = EX(X[B + 3]); PIN(X); SBAR(); } while (0)
#define VRD(i) do { vlo[i] = vtr(vp_ + (((i) >> 2) * 4096 + ((i) & 3) * 1024)); vhi[i] = vtr(vp_ + (((i) >> 2) * 4096 + ((i) & 3) * 1024 + 512)); } while (0)
#define KRD(G, j) do { if (G) { kload2(kf, kp0 + sl_next, j); SBAR(); } } while (0)
#define STEP(C0, C1, P0, P1, t, GK, GV, GL) do { SBAR(); \
    const lds_cptr vp_ = vp0 + sl_prev; \
    VRD(0); SBAR(); float sacc = (P0[0] + P0[1]); \
    GAPA(C0 = __builtin_amdgcn_mfma_f32_32x32x16_bf16(kf[0], qr[0], negm, 0, 0, 0), P0[2], P0[3], P0[4], P0[5],     pw0[0] = PKW(P0, 0), pw0[1] = PKW(P0, 2), pw0); \
    VRD(4); SBAR(); GAPA(C1 = __builtin_amdgcn_mfma_f32_32x32x16_bf16(kf[1], qr[0], negm, 0, 0, 0), P0[6], P0[7], P0[8], P0[9],     pw0[2] = PKW(P0, 4), pw0[3] = PKW(P0, 6), pw0); \
    VRD(1); SBAR(); GAPA(C0 = __builtin_amdgcn_mfma_f32_32x32x16_bf16(kf[2], qr[1], C0, 0, 0, 0),   P0[10], P0[11], P0[12], P0[13], pw1[0] = PKW(P0, 8), pw1[1] = PKW(P0, 10), pw1); \
    VRD(5); SBAR(); GAPA(C1 = __builtin_amdgcn_mfma_f32_32x32x16_bf16(kf[3], qr[1], C1, 0, 0, 0),   P0[14], P0[15], P1[0], P1[1],   pw1[2] = PKW(P0, 12), pw1[3] = PKW(P0, 14), pw1); \
    VRD(2); SBAR(); GAPA(C0 = __builtin_amdgcn_mfma_f32_32x32x16_bf16(kf[4], qr[2], C0, 0, 0, 0),   P1[2], P1[3], P1[4], P1[5],     pw2[0] = PKW(P1, 0), pw2[1] = PKW(P1, 2), pw2); \
    VRD(6); SBAR(); GAPA(C1 = __builtin_amdgcn_mfma_f32_32x32x16_bf16(kf[5], qr[2], C1, 0, 0, 0),   P1[6], P1[7], P1[8], P1[9],     pw2[2] = PKW(P1, 4), pw2[3] = PKW(P1, 6), pw2); \
    VRD(3); SBAR(); GAPA(C0 = __builtin_amdgcn_mfma_f32_32x32x16_bf16(kf[6], qr[3], C0, 0, 0, 0),   P1[10], P1[11], P1[12], P1[13], pw3[0] = PKW(P1, 8), pw3[1] = PKW(P1, 10), pw3); \
    VRD(7); SBAR(); GAPA(C1 = __builtin_amdgcn_mfma_f32_32x32x16_bf16(kf[7], qr[3], C1, 0, 0, 0),   P1[14], P1[15], 0.f, 0.f,       pw3[2] = PKW(P1, 12), pw3[3] = PKW(P1, 14), pw3); \
    l_reg += sacc; \
    if (GK) { DMA_K((t) + 3, sl_cur); } if (GV) { DMA_V((t) + 1, sl_next); } \
    CMASK(C0, C1, t); \
    { float a = MX3(C0[0], C0[1], C1[0]), b_ = MX3(C0[2], C0[3], C1[1]); a = MX3(a, C1[2], C1[3]); \
      _Pragma("unroll") for (int r = 4; r < 16; r += 4) { a = MX3(a, C0[r], C0[r + 1]); b_ = MX3(b_, C0[r + 2], C0[r + 3]); a = MX3(a, C1[r], C1[r + 1]); b_ = MX3(b_, C1[r + 2], C1[r + 3]); } \
      float rm = __builtin_fmaxf(a, b_); { auto rr = __builtin_amdgcn_permlane32_swap(__float_as_uint(rm), __float_as_uint(rm), false, false); rm = __builtin_fmaxf(__uint_as_float(rr[0]), __uint_as_float(rr[1])); } \
      resc = false; \
      const bool valid_ = rm > -1e29f; const bool need_ = valid_ && (!started || rm > (float)THRL); \
      if (__builtin_expect(__any(need_), 0)) { const float dl = valid_ ? (started ? __builtin_fmaxf(rm, 0.f) : rm) : 0.f; mhat += dl; \
        _Pragma("unroll") for (int r = 0; r < 16; ++r) { C0[r] -= dl; C1[r] -= dl; } \
        const float f = started ? __builtin_amdgcn_exp2f(-dl) : 1.0f; l_reg *= f; if (hi == 0) wsf[r32] = f; resc = true; } \
      started = started || valid_; \
      if (resc || ((((t) + 1) & 3) == 0)) SETNEGM((t) + 1); } \
    SBAR(); \
    GAPB(o[0] = __builtin_amdgcn_mfma_f32_32x32x16_bf16(PAF(0), VFR(0), o[0], 0, 0, 0), C0, 0); \
    GAPB(o[1] = __builtin_amdgcn_mfma_f32_32x32x16_bf16(PAF(0), VFR(4), o[1], 0, 0, 0), C0, 4); \
    KRD(GL, 0); GAPB(o[0] = __builtin_amdgcn_mfma_f32_32x32x16_bf16(PAF(1), VFR(1), o[0], 0, 0, 0), C0, 8); \
    KRD(GL, 1); GAPB(o[1] = __builtin_amdgcn_mfma_f32_32x32x16_bf16(PAF(1), VFR(5), o[1], 0, 0, 0), C0, 12); \
    KRD(GL, 2); GAPB(o[0] = __builtin_amdgcn_mfma_f32_32x32x16_bf16(PAF(2), VFR(2), o[0], 0, 0, 0), C1, 0); \
    KRD(GL, 3); GAPB(o[1] = __builtin_amdgcn_mfma_f32_32x32x16_bf16(PAF(2), VFR(6), o[1], 0, 0, 0), C1, 4); \
    GAPB(o[0] = __builtin_amdgcn_mfma_f32_32x32x16_bf16(PAF(3), VFR(3), o[0], 0, 0, 0), C1, 8); \
    GAPB(o[1] = __builtin_amdgcn_mfma_f32_32x32x16_bf16(PAF(3), VFR(7), o[1], 0, 0, 0), C1, 12); \
    } while (0)
            int t = 1;
#undef CMASK
#define CMASK(P0, P1, t) do { } while (0)
            for (; t + 5 < NT; t += 2) {
                STEP(pB0, pB1, pA0, pA1, t, true, true, true);     WAIT_BAR(2); RESC(); ROT();
                STEP(pA0, pA1, pB0, pB1, t + 1, true, true, true); WAIT_BAR(2); RESC(); ROT();
            }
#undef CMASK
#define CMASK(P0, P1, t) do { int jb_ = (t) - (NT - 4); if (jb_ >= 0) cmask(P0, P1, jb_, qrel, hi); } while (0)
#define ENDW(tt) do { if ((tt) + 3 < NT) { WAIT_BAR(2); } else if ((tt) + 2 < NT) { WAIT_BAR(1); } else { WAIT_BAR(0); } } while (0)
            for (; t + 1 < NT; t += 2) {
                STEP(pB0, pB1, pA0, pA1, t, (t + 3 < NT), (t + 1 < NT), (t + 1 < NT));     ENDW(t);     RESC(); ROT();
                STEP(pA0, pA1, pB0, pB1, t + 1, (t + 4 < NT), (t + 2 < NT), (t + 2 < NT)); ENDW(t + 1); RESC(); ROT();
            }
            const bool more = jbo + 1 < NBLK;
            if (more) { DMA_K(0, sl_next); DMA_V(0, sl_next); DMA_K(1, sl_prev); DMA_K(2, sl_cur); ring0 = sl_next; }
            STEP(pB0, pB1, pA0, pA1, NT - 1, false, false, false); RESC();
            if (more) { const bf16_t* Qn = Qw + (size_t)MBLK * ATT_W;
#pragma unroll
                for (int d0 = 0; d0 < 4; ++d0) qr[d0] = *(const bf16x8*)(Qn + (size_t)r32 * ATT_W + d0 * 16 + hi * 8); }
            { float sacc = pB0[0] + pB0[1];
#pragma unroll
              for (int r = 2; r < 16; ++r) sacc += pB0[r];
#pragma unroll
              for (int r = 0; r < 16; ++r) sacc += pB1[r];
              l_reg += sacc;
              pw0 = (u32x4){PKW(pB0, 0), PKW(pB0, 2), PKW(pB0, 4), PKW(pB0, 6)}; pw1 = (u32x4){PKW(pB0, 8), PKW(pB0, 10), PKW(pB0, 12), PKW(pB0, 14)};
              pw2 = (u32x4){PKW(pB1, 0), PKW(pB1, 2), PKW(pB1, 4), PKW(pB1, 6)}; pw3 = (u32x4){PKW(pB1, 8), PKW(pB1, 10), PKW(pB1, 12), PKW(pB1, 14)};
              SBAR(); pv(o, vb0 + sl_cur, PAF(0), PAF(1), PAF(2), PAF(3)); }
#undef PKW
#undef PAF
#undef VFR
#undef PIN
#undef MX3
#undef GAPA
#undef GAPB
#undef EX
#undef VRD
#undef KRD
#undef STEP
#undef ENDW
            { auto rr = __builtin_amdgcn_permlane32_swap(__float_as_uint(l_reg), __float_as_uint(l_reg), false, false); l_reg = __uint_as_float(rr[0]) + __uint_as_float(rr[1]); }
            if (hi == 0) wsf[32 + r32] = l_reg; asm volatile("s_waitcnt lgkmcnt(0)" ::: "memory");
            bf16_t* Ow = O + ((size_t)(b * SEQ + q0 + wid * 32)) * ATT_W + h * HD;
            { LAS bf16_t* stg = (LAS bf16_t*)(lds + L_OST) + wid * 2048;
#pragma unroll
              for (int r = 0; r < 16; ++r) { const int orow = crow(r, hi); const float rl = __builtin_amdgcn_rcpf(wsf[32 + orow]);
                  stg[orow * 64 + r32] = (bf16_t)(pk_bf16(o[0][r] * rl, 0.f) & 0xffffu); stg[orow * 64 + 32 + r32] = (bf16_t)(pk_bf16(o[1][r] * rl, 0.f) & 0xffffu); }
              asm volatile("s_waitcnt lgkmcnt(0)" ::: "memory");
#pragma unroll
              for (int i = 0; i < 4; ++i) { const int row = i * 8 + (lane >> 3), ch = lane & 7; const u32x4 v = *(const LAS u32x4*)(stg + row * 64 + ch * 8); *(u32x4*)(Ow + (size_t)row * ATT_W + ch * 8) = v; } }
            asm volatile("s_waitcnt lgkmcnt(0)\n\ts_barrier" ::: "memory");
#undef CMASK
#undef SETNEGM
#undef START
#undef RESC
#undef ROT
        }
#undef DMA_K
#undef DMA_V
#undef NXT
    }
}
#undef SBAR
#undef WAIT_BAR
}

#define XB_TMO      128
#define XB_XCNT(j)  (256  + 64 * (j))
#define XB_XSUB(j)  (1280 + 64 * (j))
#define XB_XGEN(j)  (2304 + 64 * (j))
#define XB_TOP      3328
#define XB_TOPGEN   3392
#define XCD_BAR_WORDS 3456
#define XB_SPIN_CAP (1u << 20)
__device__ __forceinline__ unsigned xb_ld(unsigned* p)              { return __hip_atomic_load(p, __ATOMIC_RELAXED, __HIP_MEMORY_SCOPE_AGENT); }
__device__ __forceinline__ unsigned xb_add(unsigned* p, unsigned v) { return __hip_atomic_fetch_add(p, v, __ATOMIC_RELAXED, __HIP_MEMORY_SCOPE_AGENT); }
__device__ __forceinline__ unsigned xb_xcc_id() { return (unsigned)__builtin_amdgcn_s_getreg((3 << 11) | 20) & 0xFu; }
#define XB_SPIN(cond, bar) do { unsigned _sp = 0; while (cond) { __builtin_amdgcn_s_sleep(1); \
    if ((++_sp & 255u) == 0u) { if (xb_ld(&(bar)[XB_TMO])) break; if (_sp > XB_SPIN_CAP) { atomicAdd(&(bar)[XB_TMO], 1u); break; } } } } while (0)
struct XcdBarrier { unsigned* bar; unsigned x; volatile LAS unsigned* st; };
__device__ __forceinline__ XcdBarrier xcd_barrier_post(unsigned* bar, volatile LAS unsigned* st) {
    XcdBarrier b; b.bar = bar; b.x = xb_xcc_id(); b.st = st;
    if (threadIdx.x == 0) (void)xb_add(&bar[XB_XCNT(b.x)], 1u);
    return b;
}
__device__ __forceinline__ void xcd_barrier_complete(unsigned* bar, unsigned x, unsigned& nloc, unsigned& nx) {
    const unsigned G = gridDim.x * gridDim.y * gridDim.z;
    unsigned sum, cnt, mine, sp = 0u;
    for (;;) {
        sum = 0u; cnt = 0u; mine = 0u;
#pragma unroll
        for (unsigned j = 0; j < 16; ++j) { const unsigned c = xb_ld(&bar[XB_XCNT(j)]); sum += c; cnt += (c > 0u) ? 1u : 0u; mine = (j == x) ? c : mine; }
        if (sum == G) break;
        __builtin_amdgcn_s_sleep(1);
        if ((++sp & 255u) == 0u) { if (xb_ld(&bar[XB_TMO])) break; if (sp > XB_SPIN_CAP) { atomicAdd(&bar[XB_TMO], 1u); break; } }
    }
    nloc = mine > 0u ? mine : 1u; nx = cnt > 0u ? cnt : 1u;
}
__device__ __forceinline__ void xcd_barrier(const XcdBarrier& b) {
    asm volatile("s_waitcnt vmcnt(0)" ::: "memory");
    __syncthreads();
    if (threadIdx.x == 0) {
        unsigned* bar = b.bar;
        __builtin_amdgcn_s_waitcnt(0);
        unsigned nloc = b.st[0], nx = b.st[1];
        if (nloc == 0u) { xcd_barrier_complete(bar, b.x, nloc, nx); b.st[0] = nloc; b.st[1] = nx; }
        const unsigned old = xb_add(&bar[XB_XSUB(b.x)], 1u);
        const unsigned gen = old / nloc;
        if (old + 1u == (gen + 1u) * nloc) {
            __builtin_amdgcn_fence(__ATOMIC_RELEASE, "agent");
            asm volatile("s_waitcnt vmcnt(0)" ::: "memory");
            const unsigned og = xb_add(&bar[XB_TOP], 1u);
            const unsigned tg = og / nx;
            if (og + 1u == (tg + 1u) * nx) xb_add(&bar[XB_TOPGEN], 1u);
            else XB_SPIN(xb_ld(&bar[XB_TOPGEN]) == tg, bar);
            __builtin_amdgcn_fence(__ATOMIC_ACQUIRE, "agent");
            xb_add(&bar[XB_XGEN(b.x)], 1u);
            asm volatile("s_waitcnt vmcnt(0)" ::: "memory");
        } else {
            XB_SPIN(xb_ld(&bar[XB_XGEN(b.x)]) == gen, bar);
            __builtin_amdgcn_fence(__ATOMIC_ACQUIRE, "agent");
            asm volatile("s_waitcnt vmcnt(0)" ::: "memory");
        }
    }
    __syncthreads();
}

#ifndef MK_SWAP1415
#define MK_SWAP1415 1
#endif
#ifndef MK_ST13_STATIC
#define MK_ST13_STATIC 1
#endif
constexpr int N_STAGES = 18;
__device__ __forceinline__ void wg_seam() {
    asm volatile("s_waitcnt vmcnt(0)" ::: "memory");
    __syncthreads();
    if (threadIdx.x < 64) { __builtin_amdgcn_fence(__ATOMIC_ACQUIRE, "agent"); asm volatile("s_waitcnt vmcnt(0)" ::: "memory"); }
    __syncthreads();
}
template <class Epi>
__device__ __forceinline__ void run_gemm(LAS unsigned char* lds, const bf16_t* A, int lda, const bf16_t* Bt, int ldb, int K, int nM, int nN, int pmPerGroup, size_t gstrideB, const Epi& E) {
    pg8::Gemm g{A, Bt, lda, ldb, K, nM, nN, pmPerGroup, gstrideB};
    const int pm = blockIdx.x;
    if (pm < nM) { pg8::PanelOrder S{pm, nN}; pg8::gemm_phase<Epi, pg8::PanelOrder>(lds, g, S, E); }
}
#ifndef MK_PHMASK
#define MK_PHMASK 0x3ffff
#endif
#define PH_ON(k) (((MK_PHMASK) >> (k)) & 1)
constexpr int NM = M_TOK / 256;

__device__ __forceinline__ void stage_hnorm(PArg P) {
    const int lane = threadIdx.x & 63, wave = threadIdx.x >> 6;
    const float* x = P.in(I_X); bf16_t* xb = (bf16_t*)P.out(); float* r0 = (float*)(P.ws() + WS_R0);
    for (int pm = blockIdx.x; pm < NM; pm += gridDim.x)
        for (int i = 0; i < 32; i += 4) {
            const int m0 = pm * 256 + wave * 32 + i;
            f32x4 v[4][4];
#pragma unroll
            for (int r = 0; r < 4; ++r) { const f32x4* xr = (const f32x4*)(x + (size_t)(m0 + r) * DM) + 2 * lane;
#pragma unroll
                for (int j = 0; j < 2; ++j) { v[r][2 * j] = xr[128 * j]; v[r][2 * j + 1] = xr[128 * j + 1]; } }
#pragma unroll
            for (int r = 0; r < 4; ++r) { float s = 0.f;
#pragma unroll
                for (int j = 0; j < 2; ++j) { const f32x4 a = v[r][2 * j], b = v[r][2 * j + 1];
                    s += (a.x * a.x + a.y * a.y) + (a.z * a.z + a.w * a.w) + (b.x * b.x + b.y * b.y) + (b.z * b.z + b.w * b.w);
                    u32x4 w; w.x = pk_bf16(a.x, a.y); w.y = pk_bf16(a.z, a.w); w.z = pk_bf16(b.x, b.y); w.w = pk_bf16(b.z, b.w); ((u32x4*)(xb + (size_t)(m0 + r) * DM))[lane + 64 * j] = w; }
                const float rr = rsqrtf(wave_sum(s) * (1.0f / DM) + RMS_EPS); if (lane == 0) r0[m0 + r] = rr; }
        }
}
__device__ __forceinline__ void stage_scan(PArg P) {
    const int tid = threadIdx.x; if (tid >= 256) return;
    const float* E = (const float*)(P.ws() + WS_E); bf16_t* Ap = (bf16_t*)(P.ws() + WS_AP); const float* AL = (const float*)(P.ws() + WS_AL);
    for (int pm = blockIdx.x; pm < NG * NROW_G / 256; pm += gridDim.x) {
        const int p = tid & 63, g = pm >> 3, b = 4 * (pm & 7) + (tid >> 6);
        const float ar = AL[(g * 64 + p) * 2], ai = AL[(g * 64 + p) * 2 + 1];
        float xr = 0.f, xi = 0.f; const size_t row0 = (size_t)g * NROW_G + (size_t)b * NCH;
        for (int k0 = 0; k0 < NCH; k0 += 8) {
            float er[8], ei[8];
#pragma unroll
            for (int k = 0; k < 8; ++k) { er[k] = E[(row0 + k0 + k) * 128 + p]; ei[k] = E[(row0 + k0 + k) * 128 + 64 + p]; }
#pragma unroll
            for (int k = 0; k < 8; ++k) {
                bf16_t* d = Ap + (row0 + k0 + k) * APK + p;
                d[0] = (bf16_t)(pk_bf16(xr, 0.f) & 0xffffu); d[64] = (bf16_t)(pk_bf16(xi, 0.f) & 0xffffu);
                const float nr = ar * xr - ai * xi + er[k], ni = ar * xi + ai * xr + ei[k]; xr = nr; xi = ni; }
        }
    }
}
#ifndef MK_EWR
#define MK_EWR 4
#endif
constexpr int EWR = MK_EWR;
template <int MODE>
__device__ __forceinline__ void stage_ew(PArg P, const bf16_t* XB, const bf16_t* Y, const float* g1, bf16_t* OB) {
    const int tid = threadIdx.x, lane = tid & 63, wave = tid >> 6;
    const float* rsq = (const float*)(P.ws() + WS_RSQ); float* r2o = (float*)(P.ws() + WS_R2); float* outf = P.out();
    f32x4 gv[2][2];
#pragma unroll
    for (int j = 0; j < 2; ++j) { gv[j][0] = *(const f32x4*)(g1 + (lane + 64 * j) * 8); gv[j][1] = *(const f32x4*)(g1 + (lane + 64 * j) * 8 + 4); }
    for (int pm = blockIdx.x; pm < NM; pm += gridDim.x) {
        for (int i = 0; i < 32; i += EWR) {
            const int m0 = pm * 256 + wave * 32 + i;
            u32x4 xw[EWR][2], yw[EWR][2]; float rs[EWR];
#pragma unroll
            for (int r = 0; r < EWR; ++r) { rs[r] = (lane < 16) ? rsq[(size_t)(m0 + r) * 16 + lane] : 0.f;
#pragma unroll
                for (int j = 0; j < 2; ++j) { const size_t e = (size_t)(m0 + r) * DM + (size_t)(lane + 64 * j) * 8; xw[r][j] = *(const u32x4*)(XB + e); yw[r][j] = *(const u32x4*)(Y + e); } }
#pragma unroll
            for (int r = 0; r < EWR; ++r) {
                const float rn = rsqrtf(wave_sum(rs[r]) * (1.0f / DM) + RMS_EPS);
                float s = 0.f;
#pragma unroll
                for (int j = 0; j < 2; ++j) {
                    const size_t e = (size_t)(m0 + r) * DM + (size_t)(lane + 64 * j) * 8;
                    float xv[8], yv[8], v[8]; unpack8(xw[r][j], xv); unpack8(yw[r][j], yv);
#pragma unroll
                    for (int k = 0; k < 4; ++k) { v[k] = xv[k] + yv[k] * rn * gv[j][0][k]; v[4 + k] = xv[4 + k] + yv[4 + k] * rn * gv[j][1][k]; }
                    if (MODE == 2) { *(f32x4*)(outf + e) = (f32x4){v[0], v[1], v[2], v[3]}; *(f32x4*)(outf + e + 4) = (f32x4){v[4], v[5], v[6], v[7]}; }
                    else { u32x4 w; w.x = pk_bf16(v[0], v[1]); w.y = pk_bf16(v[2], v[3]); w.z = pk_bf16(v[4], v[5]); w.w = pk_bf16(v[6], v[7]); *(u32x4*)(OB + e) = w; }
                    if (MODE == 0) {
#pragma unroll
                        for (int k = 0; k < 8; ++k) s += v[k] * v[k]; }
                }
                if (MODE == 0) { const float r2 = rsqrtf(wave_sum(s) * (1.0f / DM) + RMS_EPS); if (lane == 0) r2o[m0 + r] = r2; }
            }
        }
    }
}

__device__ __forceinline__ void stage_pconv(PArg P) {
    const int tid = threadIdx.x;
    for (int pm = blockIdx.x; pm < NM; pm += gridDim.x) {
        const f32x4* ps = (const f32x4*)(P.in(I_P) + (size_t)pm * 256 * PLE); u32x2* pd = (u32x2*)((bf16_t*)(P.ws() + WS_PB) + (size_t)pm * 256 * PLE);
#pragma unroll 4
        for (int i2 = tid; i2 < 256 * PLE / 4; i2 += NTHR) { const f32x4 v = ps[i2]; u32x2 w; w.x = pk_bf16(v.x, v.y); w.y = pk_bf16(v.z, v.w); pd[i2] = w; }
    }
}
__device__ __forceinline__ void grid_sync_probe() { cg::this_grid().sync(); }
__device__ __forceinline__ void run_stage(PArg P, LAS unsigned char* lds, int st) {
    unsigned char* ws = P.ws();
#define WSB(off) ((bf16_t*)(ws + (off)))
    switch (st) {
    case 0: if constexpr (PH_ON(0)) { if (blockIdx.x & 1) { stage_hnorm(P); __syncthreads(); phase_prep(P, lds); } else { phase_prep(P, lds); stage_hnorm(P); } } break;
    case 1: break;
    case 2: if constexpr (PH_ON(2)) { EpiIn E{WSB(WS_AP), WSB(WS_Q), WSB(WS_K), WSB(WS_V), WSB(WS_GA), WSB(WS_GB), (float*)(ws + WS_KMEAN), (const float*)(ws + WS_R0)};
              run_gemm(lds, (const bf16_t*)P.out(), DM, WSB(WS_WIN), DM, DM, NM, INC / 256, NM, 0, E); } break;
    case 3: if constexpr (PH_ON(3)) { EpiSsm1 E{(float*)(ws + WS_E)};
              run_gemm(lds, WSB(WS_AP) + 128, APK, WSB(WS_WS1), 512, 512, NG * NROW_G / 256, 1, NROW_G / 256, (size_t)256 * 512, E); } break;
    case 4: if constexpr (PH_ON(4)) stage_scan(P); break;
    case 5: if constexpr (PH_ON(5)) { EpiSsm2 E{WSB(WS_AP), P.in(I_DSK), WSB(WS_Y)};
              run_gemm(lds, WSB(WS_AP), APK, WSB(WS_WS2), APK, APK, NG * NROW_G / 256, 2, NROW_G / 256, (size_t)512 * APK, E); } break;
    case 6: if constexpr (PH_ON(6)) {
#if defined(MK_APROBE)
              att::attn_phase<MK_APROBE>(P, lds); __syncthreads();
#endif
#if MK_ATT2
#if defined(MK_APROBE2)
              { int nrep = MK_APREP; asm volatile("" : "+s"(nrep)); for (int i = 0; i < nrep; ++i) { att2::attn_phase<MK_THRL, MK_APROBE2>(P, lds); __syncthreads(); } }
#endif
              att2::attn_phase<MK_THRL, 0>(P, lds); } break;
#else
#if defined(MK_APREP)
              { int nrep = MK_APREP; asm volatile("" : "+s"(nrep)); for (int i = 0; i < nrep; ++i) { att::attn_phase<0>(P, lds); __syncthreads(); } }
#endif
              att::attn_phase<0>(P, lds); } break;
#endif
    case 7: if constexpr (PH_ON(7)) { EpiGen<EM_GLU, false> E{WSB(WS_GLU), SSM_W, WSB(WS_Y), nullptr, P.in(I_BGLU), nullptr};
              run_gemm(lds, WSB(WS_Y), SSM_W, WSB(WS_WGLU), SSM_W, SSM_W, NM, SSM_W / 256, NM, 0, E); } break;
    case 8: if constexpr (PH_ON(8)) { EpiGen<EM_GATE, false> E{WSB(WS_T1), DM, WSB(WS_GA), nullptr, nullptr, nullptr};
              run_gemm(lds, WSB(WS_GLU), SSM_W, WSB(WS_WA), SSM_W, SSM_W, NM, DM / 256, NM, 0, E); } break;
    case 9: if constexpr (PH_ON(9)) { EpiGen<EM_GATEADD, false> E{WSB(WS_MIXIN), DM, WSB(WS_GB), WSB(WS_T1), nullptr, nullptr};
              run_gemm(lds, WSB(WS_ATT), ATT_W, WSB(WS_WB), ATT_W, ATT_W, NM, DM / 256, NM, 0, E); } break;
    case 10: if constexpr (PH_ON(10)) { EpiGen<EM_PLAIN, true> E{WSB(WS_MIXED), DM, nullptr, nullptr, nullptr, (float*)(ws + WS_RSQ)};
              run_gemm(lds, WSB(WS_MIXIN), DM, WSB(WS_WOUT), DM, DM, NM, DM / 256, NM, 0, E); } break;
    case 11: if constexpr (PH_ON(11)) stage_ew<0>(P, (const bf16_t*)P.out(), WSB(WS_MIXED), P.in(I_GPOSTMIX), WSB(WS_H)); break;
    case 12: if constexpr (PH_ON(12)) {
#if defined(MK_PROBE) && (MK_PROBE == 2)
               { EpiGen<EM_PLAIN, false> EN{WSB(WS_HID), 256, nullptr, nullptr, nullptr, nullptr}; run_gemm(lds, WSB(WS_H), DM, WSB(WS_W1), DM, DM, NM, DFF / 256, NM, 0, EN); }
#elif defined(MK_PROBE)
               { EpiProbe<MK_PROBE> EN{nullptr}; run_gemm(lds, WSB(WS_H), DM, WSB(WS_W1), DM, DM, NM, DFF / 256, NM, 0, EN); }
#endif
               EpiGen<EM_RELU2, false> E{WSB(WS_HID), HID_LD, nullptr, nullptr, (const float*)(ws + WS_R2), nullptr};
               run_gemm(lds, WSB(WS_H), DM, WSB(WS_W1), DM, DM, NM, DFF / 256, NM, 0, E); } break;
    case 13: if constexpr (PH_ON(13)) {
#if defined(MK_PROBE13) && (MK_PROBE13 == 1)
               { EpiProbe<0> EN{nullptr}; run_gemm(lds, WSB(WS_HID), HID_LD, WSB(WS_W2), DFF, DFF, NM, DM / 256, NM, 0, EN); }
#elif defined(MK_PROBE13) && (MK_PROBE13 == 2)
               { EpiProbe<0> EN{nullptr}; pg8::Gemm g{WSB(WS_HID), WSB(WS_W2), HID_LD, DFF, DFF, NM, DM / 256, NM, 0}; pg8::StaticOrder S; S.init(NM, DM / 256, (int)gridDim.x, (int)blockIdx.x); grid_sync_probe(); pg8::gemm_phase<EpiProbe<0>, pg8::StaticOrder>(lds, g, S, EN); }
#endif
               EpiGen<EM_PLAIN, true> E{WSB(WS_F), DM, nullptr, nullptr, nullptr, (float*)(ws + WS_RSQ)};
#if MK_ST13_STATIC
               { pg8::Gemm g{WSB(WS_HID), WSB(WS_W2), HID_LD, DFF, DFF, NM, DM / 256, NM, 0}; pg8::StaticOrder S; S.init(NM, DM / 256, (int)gridDim.x, (int)blockIdx.x);
                 pg8::gemm_phase<EpiGen<EM_PLAIN, true>, pg8::StaticOrder>(lds, g, S, E); } } break;
#else
               run_gemm(lds, WSB(WS_HID), HID_LD, WSB(WS_W2), DFF, DFF, NM, DM / 256, NM, 0, E); } break;
#endif
    case 14: if constexpr (PH_ON(14)) stage_ew<1>(P, WSB(WS_H), WSB(WS_F), P.in(I_GPOSTMLP), WSB(WS_X2B)); break;
    case 15: if constexpr (PH_ON(15)) { stage_pconv(P); wg_seam(); EpiGen<EM_PLAIN, false> E{WSB(WS_PW), DM, nullptr, nullptr, nullptr, nullptr};
               run_gemm(lds, WSB(WS_PB), PLE, WSB(WS_WPLE), PLE, PLE, NM, DM / 256, NM, 0, E); } break;
    case 16: if constexpr (PH_ON(16)) { EpiGen<EM_MULSIG, true> E{WSB(WS_EE), DM, WSB(WS_PW), nullptr, nullptr, (float*)(ws + WS_RSQ)};
               run_gemm(lds, WSB(WS_X2B), DM, WSB(WS_WPG), DM, DM, NM, DM / 256, NM, 0, E); } break;
    case 17: if constexpr (PH_ON(17)) stage_ew<2>(P, WSB(WS_X2B), WSB(WS_EE), P.in(I_GPLE), nullptr); break;
    default: break;
    }
#undef WSB
}

__global__ void __launch_bounds__(NTHR, 2) mk_fwd(Params Pval) {
    extern __shared__ __attribute__((aligned(16))) unsigned char lds_raw[];
    LAS unsigned char* lds = (LAS unsigned char*)lds_raw;
    {
        const __attribute__((address_space(4))) unsigned* ka = (const __attribute__((address_space(4))) unsigned*)__builtin_amdgcn_kernarg_segment_ptr();
        if (threadIdx.x < 54) ((LAS unsigned*)(lds + LDS_PARAM_OFF))[threadIdx.x] = ka[threadIdx.x];
        else if (threadIdx.x < 64) ((LAS unsigned*)(lds + LDS_PARAM_OFF))[threadIdx.x] = 0u;
        __syncthreads();
    }
    const PArg P{(const LAS unsigned*)(lds + LDS_PARAM_OFF)};
#ifndef MK_XCDBAR
#define MK_XCDBAR 1
#endif
    XcdBarrier xbar = xcd_barrier_post((unsigned*)(P.ws() + WS_BAR), (volatile LAS unsigned*)(lds + LDS_PARAM_OFF + 224));
    cg::grid_group grid = cg::this_grid();
#ifndef MK_REPMASK
#define MK_REPMASK 0
#endif
#define MK_SYNC(k, GRIDSYNC) { if (GRIDSYNC) { if (MK_XCDBAR && Pval.ph_hi <= N_STAGES) xcd_barrier(xbar); else grid.sync(); } else wg_seam(); }
#define MK_STAGE(k, GRIDSYNC) if (Pval.ph_lo <= (k) && (k) < Pval.ph_hi) { \
        if constexpr (((MK_REPMASK) >> (k)) & 1) { run_stage(P, lds, (k)); MK_SYNC(k, GRIDSYNC) }     \
        run_stage(P, lds, (k)); if ((k) + 1 < Pval.ph_hi) MK_SYNC(k, GRIDSYNC) }
    MK_STAGE(0, true) MK_STAGE(1, false) MK_STAGE(2, true) MK_STAGE(3, false) MK_STAGE(4, false) MK_STAGE(5, false) MK_STAGE(6, true)
    MK_STAGE(7, false) MK_STAGE(8, false) MK_STAGE(9, false) MK_STAGE(10, false) MK_STAGE(11, true) MK_STAGE(12, MK_ST13_STATIC != 0) MK_STAGE(13, MK_ST13_STATIC != 0)
    if (Pval.ph_lo <= 14 && 16 <= Pval.ph_hi && MK_SWAP1415 && ((blockIdx.x >> 3) & 1)) {
        run_stage(P, lds, 15); wg_seam(); run_stage(P, lds, 14); if (16 < Pval.ph_hi) wg_seam();
    } else { MK_STAGE(14, false) MK_STAGE(15, false) }
    MK_STAGE(16, false) MK_STAGE(17, false)
#undef MK_STAGE
#undef MK_SYNC
}


extern "C" void kernel_launch(void* const* d_in, const int* in_sizes, int n_in, void* d_out, int out_size, void* d_ws, size_t ws_size, hipStream_t stream) {
    static int grid = 0;
    if (grid == 0) {
        if (n_in != 25 || out_size != M_TOK * DM || ws_size < WS_END) { fprintf(stderr, "kernel_launch: unexpected shapes (n_in %d out %d ws %zu)\n", n_in, out_size, ws_size); grid = -1; return; }
        int dev = 0, cus = 0, per_cu = 0;
        hipGetDevice(&dev); hipDeviceGetAttribute(&cus, hipDeviceAttributeMultiprocessorCount, dev);
        hipFuncSetAttribute((const void*)mk_fwd, hipFuncAttributeMaxDynamicSharedMemorySize, LDS_BYTES);
        hipOccupancyMaxActiveBlocksPerMultiprocessor(&per_cu, (const void*)mk_fwd, NTHR, LDS_BYTES);
        if (per_cu < 1) { fprintf(stderr, "kernel_launch: occupancy query says %d blocks/CU\n", per_cu); per_cu = 1; }
        grid = NM_PANELS;
        if (cus != NM_PANELS) fprintf(stderr, "kernel_launch: device reports %d CUs; this kernel is laid out for %d\n", cus, NM_PANELS);
        (void)hipGetLastError();
    }
    if (grid < 0) return;
    Params p{};
    for (int i = 0; i < 25; ++i) p.in[i] = (const float*)d_in[i];
    p.out = (float*)d_out; p.ws = (unsigned char*)d_ws;
    (void)hipMemsetAsync((char*)d_ws + WS_BAR, 0, 16384, stream);
#if MK_DEBUG
    dbg_run(p, grid, stream);
#elif MK_LAUNCHES == 1
    p.ph_lo = 0; p.ph_hi = N_STAGES;
    void* args[] = {&p};
    hipError_t e = hipLaunchCooperativeKernel((const void*)mk_fwd, dim3(grid), dim3(NTHR), args, LDS_BYTES, stream);
    if (e != hipSuccess) fprintf(stderr, "cooperative launch failed: %s (grid %d)\n", hipGetErrorString(e), grid);
#else
    for (int ph = 0; ph < N_STAGES; ++ph) { p.ph_lo = ph; p.ph_hi = ph + 1; hipLaunchKernelGGL(mk_fwd, dim3(grid), dim3(NTHR), LDS_BYTES, stream, p); }
#endif
}
```

```cpp
#include <hip/hip_runtime.h>
#include <hip/hip_cooperative_groups.h>
#include <cstdio>
#include <cstdint>
namespace cg = cooperative_groups;

#ifndef MK_DEBUG
#define MK_DEBUG 0
#endif
#ifndef MK_NTGATE
#define MK_NTGATE 1
#endif
#ifndef MK_NT
#define MK_NT 1
#endif
#ifndef MK_LAUNCHES
#define MK_LAUNCHES 1
#endif

#define LAS __attribute__((address_space(3)))
typedef unsigned short bf16_t;
typedef short bf16x8 __attribute__((ext_vector_type(8)));
typedef short s16x4 __attribute__((ext_vector_type(4)));
typedef float f32x4 __attribute__((ext_vector_type(4)));
typedef float f32x16 __attribute__((ext_vector_type(16)));
typedef unsigned u32x4 __attribute__((ext_vector_type(4)));
typedef unsigned u32x2 __attribute__((ext_vector_type(2)));
typedef float f32x2_t __attribute__((ext_vector_type(2)));
typedef __bf16 bf16x2_t __attribute__((ext_vector_type(2)));

constexpr int BATCH = 32, SEQ = 2048, DM = 1024, M_TOK = BATCH * SEQ;
constexpr int SSM_W = 512, NG = 32, GC = 16, NSTATE = 64;
constexpr int NHEAD = 8, HD = 64, ATT_W = 512, MBLK = 256, NBLK = 8;
constexpr int DFF = 4096, PLE = 256, INC = 4096;
constexpr float RMS_EPS = 1e-6f;
constexpr int CL = 32;
constexpr int NCH = SEQ / CL;
constexpr int NROW_G = BATCH * NCH;
constexpr int APK = 128 + CL * GC;
constexpr int NM_PANELS = M_TOK / 256;
constexpr float QSCALE = 0.125f * 1.4426950408889634f;

#ifndef MK_HNW
#define MK_HNW 8
#endif
constexpr size_t MiB = 1u << 20;
constexpr size_t WS_WIN = 0, WS_W1 = 8 * MiB, WS_W2 = 16 * MiB, WS_WOUT = 24 * MiB, WS_WPG = 26 * MiB, WS_WA = 28 * MiB, WS_WB = 29 * MiB;
constexpr size_t WS_WGLU = 30 * MiB, WS_WPLE = 30 * MiB + 512 * 1024, WS_WS1 = 31 * MiB, WS_WS2 = 39 * MiB;
constexpr size_t WS_AL = 59 * MiB, WS_R0 = 59 * MiB + 65536, WS_R2 = 59 * MiB + 65536 + 262144, WS_RSQ = 60 * MiB, WS_PB = 64 * MiB;
constexpr size_t WS_SC = 96 * MiB, WS_SA = 736 * MiB, WS_SB = 864 * MiB;
constexpr size_t WS_H = WS_SC, WS_T1 = WS_SC;
constexpr size_t WS_PW = 224 * MiB;
constexpr size_t WS_GA = WS_SA, WS_MIXIN = WS_SA, WS_F = WS_SA, WS_EE = WS_SA;
constexpr size_t WS_GB = WS_SB, WS_MIXED = WS_SB, WS_X2B = WS_SB;
constexpr size_t WS_AP = 224 * MiB, WS_E = 304 * MiB, WS_Q = 336 * MiB, WS_K = 400 * MiB, WS_V = 464 * MiB, WS_Y = 528 * MiB, WS_ATT = 592 * MiB;
constexpr size_t WS_GLU = WS_Q;
constexpr int HID_LD = DFF;
constexpr size_t WS_HID = 224 * MiB;
constexpr size_t WS_KMEAN = 992 * MiB;
constexpr size_t WS_BAR = 993 * MiB;
constexpr size_t WS_END = 994 * MiB;
static_assert(WS_V - WS_K == WS_K - WS_Q, "Q|K|V equally spaced");

__device__ __forceinline__ unsigned pk_bf16(float lo, float hi) { f32x2_t v = {lo, hi}; bf16x2_t b = __builtin_convertvector(v, bf16x2_t); return __builtin_bit_cast(unsigned, b); }
__device__ __forceinline__ float bf_lo(unsigned w) { return __uint_as_float(w << 16); }
__device__ __forceinline__ float bf_hi(unsigned w) { return __uint_as_float(w & 0xffff0000u); }
__device__ __forceinline__ float bf_round(float x) { return bf_lo(pk_bf16(x, 0.f) & 0xffffu); }
__device__ __forceinline__ float fsigmoid(float x) { return __builtin_amdgcn_rcpf(1.0f + __builtin_amdgcn_exp2f(-1.4426950408889634f * x)); }
__device__ __forceinline__ float gelu_tanh(float y) { const float z = 0.7978845608028654f * (y + 0.044715f * y * y * y); return y * __builtin_amdgcn_rcpf(1.0f + __builtin_amdgcn_exp2f(-2.885390081777927f * z)); }
__device__ __forceinline__ float wave_sum(float v) {
#pragma unroll
    for (int o = 1; o < 64; o <<= 1) v += __shfl_xor(v, o);
    return v;
}
__device__ __forceinline__ void unpack8(const u32x4 w, float* f) { f[0] = bf_lo(w.x); f[1] = bf_hi(w.x); f[2] = bf_lo(w.y); f[3] = bf_hi(w.y); f[4] = bf_lo(w.z); f[5] = bf_hi(w.z); f[6] = bf_lo(w.w); f[7] = bf_hi(w.w); }

namespace pg8 {
constexpr int BM = 256, BK = 64, HALF = 128, HTB = HALF * BK * 2, STAGE_BYTES = 8 * HTB, NXCD = 8, WGM = 8;
__device__ __forceinline__ int lds_byte(int r, int c) { const int st = (r >> 4) * 2 + (c >> 5), rr = r & 15, cc = c & 31, ob = rr * 64 + cc * 2; return st * 1024 + (ob ^ (((ob >> 9) & 1) << 5)); }
__device__ __forceinline__ void stage_rc(int b, int& R, int& C) { const int st = b / 1024, sb = b % 1024, swz = sb ^ (((sb >> 9) & 1) << 5); R = (st >> 1) * 16 + swz / 64; C = (st & 1) * 32 + (swz % 64) / 2; }
__device__ __forceinline__ int perm32(int rho) { const int n = rho >> 4, i = rho & 15; return 8 * (i >> 2) + 4 * n + (i & 3); }

struct Unit { int pm, pn; };
struct Gemm { const bf16_t* A; const bf16_t* Bt; int lda, ldb, K, nM, nN, pmPerGroup; size_t gstrideB; };

struct StaticOrder {
    int nM, nN, nwg, G, c;
    __device__ void init(int nM_, int nN_, int G_, int c_) { nM = nM_; nN = nN_; nwg = nM * nN; G = G_; c = c_; }
    __device__ bool next(int i, Unit& u) const {
        const long L = (long)i * G + c; if (L >= nwg) return false;
        int wgid = (int)L; { const int q = nwg / NXCD, r = nwg % NXCD, xcd = wgid % NXCD, off = wgid / NXCD; wgid = (xcd < r ? xcd * (q + 1) : r * (q + 1) + (xcd - r) * q) + off; }
        const int nig = WGM * nN, gid = wgid / nig, fm = gid * WGM, gsz = (nM - fm) < WGM ? (nM - fm) : WGM;
        u.pm = fm + ((wgid % nig) % gsz); u.pn = (wgid % nig) / gsz; return true;
    }
};

struct PanelOrder {
    int pm, nN;
    __device__ bool next(int i, Unit& u) const { if (i >= nN) return false; int pmo = pm; asm volatile("" : "+s"(pmo)); u.pm = pmo; u.pn = i; return true; }
};
template <class Epi, class Sched>
__device__ __forceinline__ void gemm_phase(LAS unsigned char* lds, const Gemm g, const Sched& S, const Epi& E) {
    const int tid = threadIdx.x, wid = __builtin_amdgcn_readfirstlane(tid >> 6), lane = tid & 63, wr = wid >> 2, wc = wid & 3, fr = lane & 15, fq = lane >> 4;
    int K = g.K; asm volatile("" : "+s"(K));
    const int nt = K / BK;
    unsigned voffA[2], voffB[2];
#pragma unroll
    for (int i = 0; i < 2; ++i) { int R, C; stage_rc(tid * 16 + i * 8192, R, C); const int Rb = Epi::PERM ? ((R & ~31) + perm32(R & 31)) : R;
        voffA[i] = (unsigned)(R * g.lda + C) * 2u; voffB[i] = (unsigned)(Rb * g.ldb + C) * 2u; }
    const size_t kstep = (size_t)(BK * 2);
    const size_t hstepA = (size_t)HALF * g.lda * 2, tstepA = 2 * hstepA;
    const size_t hstepB = (size_t)HALF * g.ldb * 2, tstepB = 2 * hstepB;
    const unsigned ldsw = (unsigned)wid * 1024u;
    const int aoff = lds_byte(wr * 64 + fr, fq * 8), boff = lds_byte(wc * 32 + fr, fq * 8);
#define PG8_SA(b, h) (((b) * 2 + (h)) * HTB)
#define PG8_SB(b, h) ((4 + (b) * 2 + (h)) * HTB)
#define PG8_STAGE(bufoff, gbase, voff) do { _Pragma("unroll") for (int _i = 0; _i < 2; ++_i) \
        __builtin_amdgcn_global_load_lds((const unsigned*)((const char*)(gbase) + (voff)[_i]), (LAS unsigned*)(lds + (bufoff) + ldsw + _i * 8192), 16, 0, 0); } while (0)
#define PG8_LDA(dst, b, h) do { _Pragma("unroll") for (int m = 0; m < 4; ++m) _Pragma("unroll") for (int k = 0; k < 2; ++k) dst[m][k] = *(const LAS bf16x8*)(lds + PG8_SA(b, h) + aoff + m * 2048 + k * 1024); } while (0)
#define PG8_LDB(dst, b, h) do { _Pragma("unroll") for (int n = 0; n < 2; ++n) _Pragma("unroll") for (int k = 0; k < 2; ++k) dst[n][k] = *(const LAS bf16x8*)(lds + PG8_SB(b, h) + boff + n * 2048 + k * 1024); } while (0)
#define PG8_MMA(ai, bj, At, Bt) do { __builtin_amdgcn_s_setprio(1); _Pragma("unroll") for (int m = 0; m < 4; ++m) _Pragma("unroll") for (int n = 0; n < 2; ++n) _Pragma("unroll") for (int k = 0; k < 2; ++k) \
        acc[ai][bj][m][n] = __builtin_amdgcn_mfma_f32_16x16x32_bf16(Bt[n][k], At[m][k], acc[ai][bj][m][n], 0, 0, 0); __builtin_amdgcn_s_setprio(0); } while (0)
#define PG8_WAIT_V(n) asm volatile("s_waitcnt vmcnt(" #n ")" ::: "memory")
#define PG8_WAIT_L(n) asm volatile("s_waitcnt lgkmcnt(" #n ")" ::: "memory")
#define PG8_BAR __builtin_amdgcn_s_barrier()
#define PG8_SCHED __builtin_amdgcn_sched_barrier(0)
#define PG8_ABASE(u) ((const char*)g.A + (size_t)(u).pm * tstepA)
#define PG8_BBASE(u) ((const char*)g.Bt + (size_t)((u).pm / g.pmPerGroup) * g.gstrideB * 2 + (size_t)(u).pn * tstepB)
    Unit cur, nxt; int ui = 0;
    if (!S.next(0, cur)) return;
    f32x4 acc[2][2][4][2];
#pragma unroll
    for (int a = 0; a < 2; ++a)
#pragma unroll
        for (int b = 0; b < 2; ++b)
#pragma unroll
            for (int m = 0; m < 4; ++m)
#pragma unroll
                for (int n = 0; n < 2; ++n) acc[a][b][m][n] = (f32x4){0.f, 0.f, 0.f, 0.f};
    bf16x8 At[4][2], B0[2][2], B1[2][2];
    const char* cA = PG8_ABASE(cur); const char* cB = PG8_BBASE(cur);
    PG8_STAGE(PG8_SB(0, 0), cB, voffB); PG8_STAGE(PG8_SB(0, 1), cB + hstepB, voffB); PG8_STAGE(PG8_SA(0, 0), cA, voffA); PG8_STAGE(PG8_SA(0, 1), cA + hstepA, voffA);
    if (wr == 1) PG8_BAR;
    PG8_WAIT_V(2); PG8_BAR;
    PG8_STAGE(PG8_SB(1, 0), cB + kstep, voffB); PG8_STAGE(PG8_SA(1, 0), cA + kstep, voffA); PG8_STAGE(PG8_SB(1, 1), cB + hstepB + kstep, voffB);
    PG8_WAIT_V(6); PG8_BAR;
    for (;;) {
        const bool has_next = S.next(ui + 1, nxt);
        const char* nA = has_next ? PG8_ABASE(nxt) : cA; const char* nB = has_next ? PG8_BBASE(nxt) : cB;
        for (int t = 0; t < nt; t += 2) {
            const bool last = (t == nt - 2);
            const char* a1 = cA + (size_t)(t + 1) * kstep;
            const char* a2 = last ? nA : cA + (size_t)(t + 2) * kstep; const char* b2 = last ? nB : cB + (size_t)(t + 2) * kstep;
            const char* a3 = a2 + kstep; const char* b3 = b2 + kstep;
            PG8_LDB(B0, 0, 0); PG8_LDB(B1, 0, 1); PG8_SCHED; PG8_LDA(At, 0, 0); PG8_STAGE(PG8_SA(1, 1), a1 + hstepA, voffA);
            PG8_WAIT_V(8); PG8_WAIT_L(0); PG8_BAR; PG8_MMA(0, 0, At, B0); PG8_MMA(0, 1, At, B1); PG8_BAR; PG8_SCHED;
            PG8_LDA(At, 0, 1); PG8_STAGE(PG8_SB(0, 0), b2, voffB); PG8_STAGE(PG8_SB(0, 1), b2 + hstepB, voffB); PG8_STAGE(PG8_SA(0, 0), a2, voffA);
            PG8_WAIT_V(8); PG8_WAIT_L(0); PG8_BAR; PG8_MMA(1, 0, At, B0); PG8_MMA(1, 1, At, B1); PG8_BAR; PG8_SCHED;
            PG8_LDB(B0, 1, 0); PG8_LDB(B1, 1, 1); PG8_SCHED; PG8_LDA(At, 1, 0); PG8_STAGE(PG8_SA(0, 1), a2 + hstepA, voffA);
            PG8_WAIT_V(8); PG8_WAIT_L(0); PG8_BAR; PG8_MMA(0, 0, At, B0); PG8_MMA(0, 1, At, B1); PG8_BAR; PG8_SCHED;
            PG8_LDA(At, 1, 1); PG8_STAGE(PG8_SB(1, 0), b3, voffB); PG8_STAGE(PG8_SB(1, 1), b3 + hstepB, voffB); PG8_STAGE(PG8_SA(1, 0), a3, voffA);
            PG8_WAIT_V(8); PG8_WAIT_L(0); PG8_BAR; PG8_MMA(1, 0, At, B0); PG8_MMA(1, 1, At, B1); PG8_BAR; PG8_SCHED;
        }
        if (wr == 0) PG8_BAR;
        E(acc, cur, wr, wc, fr, fq);
        if (!has_next) break;
#pragma unroll
        for (int a = 0; a < 2; ++a)
#pragma unroll
            for (int b = 0; b < 2; ++b)
#pragma unroll
                for (int m = 0; m < 4; ++m)
#pragma unroll
                    for (int n = 0; n < 2; ++n) acc[a][b][m][n] = (f32x4){0.f, 0.f, 0.f, 0.f};
        cur = nxt; cA = nA; cB = nB; ++ui;
        if (wr == 1) PG8_BAR;
    }
    PG8_WAIT_V(0);
    PG8_BAR;
#undef PG8_SA
#undef PG8_SB
#undef PG8_STAGE
#undef PG8_LDA
#undef PG8_LDB
#undef PG8_MMA
#undef PG8_WAIT_V
#undef PG8_WAIT_L
#undef PG8_BAR
#undef PG8_SCHED
#undef PG8_ABASE
#undef PG8_BBASE
}
}

typedef const f32x4 (&AccRef)[2][2][4][2];
#ifndef MK_NTQKV
#define MK_NTQKV 0
#endif
#if MK_NTQKV
#define EPI_ST(p, v) __builtin_nontemporal_store((v), (p))
#else
#define EPI_ST(p, v) (*(p) = (v))
#endif
#define EPI_ROWS(ai, m) for (int ai = 0; ai < 2; ++ai) _Pragma("unroll") for (int m = 0; m < 4; ++m)
__device__ __forceinline__ u32x4 pack8(const f32x4 a, const f32x4 b) { u32x4 w; w.x = pk_bf16(a[0], a[1]); w.y = pk_bf16(a[2], a[3]); w.z = pk_bf16(b[0], b[1]); w.w = pk_bf16(b[2], b[3]); return w; }

struct EpiIn {
    static constexpr bool PERM = true;
    bf16_t* Ap; bf16_t* Q; bf16_t* Kb; bf16_t* Vb; bf16_t* GA; bf16_t* GB; float* kmean; const float* r0;
    __device__ __forceinline__ void operator()(AccRef acc_, const pg8::Unit& u, int wr, int wc, int fr, int fq) const {
        const int pn = u.pn, row0 = u.pm * 256 + wr * 64 + fr, colw = wc * 32 + 8 * fq;
        f32x4 acc[2][2][4][2];
#pragma unroll
        EPI_ROWS(ai, m) { const float rs = r0[row0 + ai * 128 + m * 16];
#pragma unroll
            for (int bj = 0; bj < 2; ++bj) { acc[ai][bj][m][0] = acc_[ai][bj][m][0] * rs; acc[ai][bj][m][1] = acc_[ai][bj][m][1] * rs; } }
        if (pn < 2) {
            const int b = u.pm >> 3, s0 = (u.pm & 7) * 256 + wr * 64 + fr;
#pragma unroll
            EPI_ROWS(ai, m) { const int s = s0 + ai * 128 + m * 16, n = b * NCH + (s >> 5), i = s & 31;
#pragma unroll
                for (int bj = 0; bj < 2; ++bj) { const int col = pn * 256 + bj * 128 + colw, gg = col >> 4, c0 = col & 15;
                    *(u32x4*)(Ap + ((size_t)(gg * NROW_G + n)) * APK + 128 + i * 16 + c0) = pack8(acc[ai][bj][m][0], acc[ai][bj][m][1]); } }
        } else if (pn < 8) {
            bf16_t* dst = Q + (size_t)((pn - 2) >> 1) * ((WS_K - WS_Q) / 2); const int cbase = (pn & 1) * 256 + colw; const float sc = (pn < 4) ? QSCALE : 1.0f;
#pragma unroll
            EPI_ROWS(ai, m) { const size_t row = (size_t)(row0 + ai * 128 + m * 16);
#pragma unroll
                for (int bj = 0; bj < 2; ++bj) EPI_ST((u32x4*)(dst + row * 512 + cbase + bj * 128), pack8(acc[ai][bj][m][0] * sc, acc[ai][bj][m][1] * sc)); }
            if (pn == 4 || pn == 5) {
                f32x4 c00 = (f32x4){0.f, 0.f, 0.f, 0.f}, c01 = c00, c10 = c00, c11 = c00;
#pragma unroll
                EPI_ROWS(ai, m) { c00 += acc[ai][0][m][0]; c01 += acc[ai][0][m][1]; c10 += acc[ai][1][m][0]; c11 += acc[ai][1][m][1]; }
#pragma unroll
                for (int j = 0; j < 4; ++j) {
                    float a = c00[j], b = c01[j], c = c10[j], d = c11[j];
#pragma unroll
                    for (int o = 1; o < 16; o <<= 1) { a += __shfl_xor(a, o); b += __shfl_xor(b, o); c += __shfl_xor(c, o); d += __shfl_xor(d, o); }
                    c00[j] = a; c01[j] = b; c10[j] = c; c11[j] = d;
                }
                if (fr == 0) {
                    float* km = kmean + ((size_t)wr * NM_PANELS + u.pm) * 512 + cbase;
                    *(f32x4*)(km) = c00 * (1.0f / 256.0f); *(f32x4*)(km + 4) = c01 * (1.0f / 256.0f); *(f32x4*)(km + 128) = c10 * (1.0f / 256.0f); *(f32x4*)(km + 132) = c11 * (1.0f / 256.0f);
                }
            }
        } else {
            bf16_t* dst = GA + (size_t)((pn - 8) >> 2) * ((WS_GB - WS_GA) / 2); const int cbase = ((pn - 8) & 3) * 256 + colw;
#pragma unroll
            EPI_ROWS(ai, m) { const size_t row = (size_t)(row0 + ai * 128 + m * 16);
#pragma unroll
                for (int bj = 0; bj < 2; ++bj) { f32x4 a = acc[ai][bj][m][0], c = acc[ai][bj][m][1];
#pragma unroll
                    for (int j = 0; j < 4; ++j) { a[j] = fsigmoid(a[j]); c[j] = fsigmoid(c[j]); }
#if MK_NTGATE
                    __builtin_nontemporal_store(pack8(a, c), (u32x4*)(dst + row * 1024 + cbase + bj * 128)); } }
#else
                    EPI_ST((u32x4*)(dst + row * 1024 + cbase + bj * 128), pack8(a, c)); } }
#endif
        }
    }
};
struct EpiSsm1 {
    static constexpr bool PERM = false;
    float* E;
    __device__ __forceinline__ void operator()(AccRef acc, const pg8::Unit& u, int wr, int wc, int fr, int fq) const {
        const int row0 = u.pm * 256 + wr * 64 + fr, col0 = wc * 32 + 4 * fq;
#pragma unroll
        EPI_ROWS(ai, m) { float* rp = E + (size_t)(row0 + ai * 128 + m * 16) * 128 + col0;
#pragma unroll
            for (int n = 0; n < 2; ++n) *(f32x4*)(rp + n * 16) = acc[ai][0][m][n]; }
    }
};
struct EpiSsm2 {
    static constexpr bool PERM = true;
    const bf16_t* Ap; const float* dsk; bf16_t* Y;
    __device__ __forceinline__ void operator()(AccRef acc, const pg8::Unit& u, int wr, int wc, int fr, int fq) const {
        const int gg = u.pm >> 3, nl0 = (u.pm & 7) * 256 + wr * 64 + fr;
#pragma unroll
        for (int bj = 0; bj < 2; ++bj) {
            const int col = u.pn * 256 + bj * 128 + wc * 32 + 8 * fq, i = col >> 4, c0 = col & 15;
            const f32x4 d0 = *(const f32x4*)(dsk + gg * 16 + c0), d1 = *(const f32x4*)(dsk + gg * 16 + c0 + 4);
#pragma unroll
            EPI_ROWS(ai, m) { const int n = nl0 + ai * 128 + m * 16, b = n >> 6, ch = n & 63;
                const u32x4 uw = *(const u32x4*)(Ap + ((size_t)(gg * NROW_G + n)) * APK + 128 + col);
                float uf[8]; unpack8(uw, uf);
                f32x4 a = acc[ai][bj][m][0], c = acc[ai][bj][m][1];
#pragma unroll
                for (int j = 0; j < 4; ++j) { a[j] = gelu_tanh(a[j] + d0[j] * uf[j]); c[j] = gelu_tanh(c[j] + d1[j] * uf[4 + j]); }
                *(u32x4*)(Y + ((size_t)(b * SEQ + ch * CL + i)) * SSM_W + gg * 16 + c0) = pack8(a, c);
                if (m & 1) asm volatile("" ::: "memory"); }
        }
    }
};
enum { EM_PLAIN = 0, EM_GLU = 1, EM_GATE = 2, EM_GATEADD = 3, EM_RELU2 = 4, EM_MULSIG = 5 };
template <int MODE, bool ROWSQ>
struct EpiGen {
    static constexpr bool PERM = true;
    bf16_t* O; int ldc; const bf16_t* X1; const bf16_t* X2; const float* bias; float* rsq;
    __device__ __forceinline__ void operator()(AccRef acc, const pg8::Unit& u, int wr, int wc, int fr, int fq) const {
        const int row0 = u.pm * 256 + wr * 64 + fr, col0 = u.pn * 256 + wc * 32 + 8 * fq;
        float bv[2][8];
        if (MODE == EM_GLU) {
#pragma unroll
            for (int bj = 0; bj < 2; ++bj) { const f32x4 b0 = *(const f32x4*)(bias + col0 + bj * 128), b1 = *(const f32x4*)(bias + col0 + bj * 128 + 4);
#pragma unroll
                for (int j = 0; j < 4; ++j) { bv[bj][j] = b0[j]; bv[bj][4 + j] = b1[j]; } }
        }
#pragma unroll
        EPI_ROWS(ai, m) { const size_t off = (size_t)(row0 + ai * 128 + m * 16) * ldc + col0; float sq = 0.f;
#pragma unroll
            for (int bj = 0; bj < 2; ++bj) {
                float v[8];
#pragma unroll
                for (int j = 0; j < 4; ++j) { v[j] = acc[ai][bj][m][0][j]; v[4 + j] = acc[ai][bj][m][1][j]; }
                if (MODE == EM_GLU) { float x[8]; unpack8(*(const u32x4*)(X1 + off + bj * 128), x);
#pragma unroll
                    for (int j = 0; j < 8; ++j) v[j] = x[j] * fsigmoid(v[j] + bv[bj][j]); }
                if (MODE == EM_GATE) { float x[8]; unpack8(*(const u32x4*)(X1 + off + bj * 128), x);
#pragma unroll
                    for (int j = 0; j < 8; ++j) v[j] = x[j] * v[j]; }
                if (MODE == EM_GATEADD) { float x[8], t[8]; unpack8(*(const u32x4*)(X1 + off + bj * 128), x); unpack8(*(const u32x4*)(X2 + off + bj * 128), t);
#pragma unroll
                    for (int j = 0; j < 8; ++j) v[j] = t[j] + x[j] * v[j]; }
                if (MODE == EM_RELU2) { const float rs = bias[row0 + ai * 128 + m * 16];
#pragma unroll
                    for (int j = 0; j < 8; ++j) { const float r = fmaxf(v[j], 0.f) * rs; v[j] = r * r; } }
                if (MODE == EM_MULSIG) { float x[8]; unpack8(*(const u32x4*)(X1 + off + bj * 128), x);
#pragma unroll
                    for (int j = 0; j < 8; ++j) v[j] = x[j] * fsigmoid(v[j]); }
                if (ROWSQ) {
#pragma unroll
                    for (int j = 0; j < 8; ++j) sq += v[j] * v[j]; }
                u32x4 w; w.x = pk_bf16(v[0], v[1]); w.y = pk_bf16(v[2], v[3]); w.z = pk_bf16(v[4], v[5]); w.w = pk_bf16(v[6], v[7]);
#if defined(MK_NT)
                if (MODE == EM_RELU2 || MK_NT >= 2) __builtin_nontemporal_store(w, (u32x4*)(O + off + bj * 128)); else
#endif
                *(u32x4*)(O + off + bj * 128) = w;
            }
            if (ROWSQ) { sq += __shfl_xor(sq, 16); sq += __shfl_xor(sq, 32);
                if (fq == 0) rsq[(size_t)(row0 + ai * 128 + m * 16) * 16 + u.pn * 4 + wc] = sq; }
            if (m & 1) asm volatile("" ::: "memory");
        }
    }
};

template <int VARIANT>
struct EpiProbe {
    static constexpr bool PERM = true;
    bf16_t* scratch;
    __device__ __forceinline__ void operator()(AccRef acc, const pg8::Unit& u, int wr, int wc, int fr, int fq) const {
#pragma unroll
        EPI_ROWS(ai, m)
#pragma unroll
            for (int bj = 0; bj < 2; ++bj) {
                if (VARIANT == 0) asm volatile("" :: "v"(acc[ai][bj][m][0]), "v"(acc[ai][bj][m][1]));
                if (VARIANT == 1) { f32x4 a = acc[ai][bj][m][0], c = acc[ai][bj][m][1];
#pragma unroll
                    for (int j = 0; j < 4; ++j) { const float r0 = fmaxf(a[j], 0.f) * 1.01f, r1 = fmaxf(c[j], 0.f) * 1.01f; a[j] = r0 * r0; c[j] = r1 * r1; }
                    const u32x4 w = pack8(a, c); asm volatile("" :: "v"(w)); }
                if (VARIANT == 2) { const u32x4 w = pack8(acc[ai][bj][m][0], acc[ai][bj][m][1]);
                    bf16_t* sp = scratch + (size_t)blockIdx.x * 65536 + (wr * 64 + fr) * 256 + wc * 32 + 8 * fq;
                    *(u32x4*)(sp + (ai * 128 + m * 16) * 256 + bj * 128) = w; if (bj) asm volatile("" ::: "memory"); }
            }
    }
};
struct Params { const float* in[25]; float* out; unsigned char* ws; int ph_lo, ph_hi; };
constexpr int LDS_PARAM_OFF = 131072;
struct PArg {
    const LAS unsigned* b;
    __device__ __forceinline__ unsigned long long q(int i) const { const unsigned lo = __builtin_amdgcn_readfirstlane(b[2 * i]), hi = __builtin_amdgcn_readfirstlane(b[2 * i + 1]); return ((unsigned long long)hi << 32) | lo; }
    __device__ __forceinline__ const float* in(int i) const { return (const float*)(const __attribute__((address_space(1))) float*)q(i); }
    __device__ __forceinline__ float* out() const { return (float*)(__attribute__((address_space(1))) float*)q(25); }
    __device__ __forceinline__ unsigned char* ws() const { return (unsigned char*)(__attribute__((address_space(1))) unsigned char*)q(26); }
};
constexpr int NWAVES = 8, NTHR = 512;
constexpr int LDS_BYTES = 131072 + 4096;
enum { I_X = 0, I_P, I_GPRE, I_WIN, I_LRE, I_LIM, I_LDT, I_BRE, I_BIM, I_CRE, I_CIM, I_DSK, I_WGLU, I_BGLU, I_WA, I_WB, I_WOUT, I_GPOSTMIX, I_GPREMLP, I_W1, I_W2, I_GPOSTMLP, I_WPLE, I_WPG, I_GPLE };

__device__ __forceinline__ void transpose_item(const float* W, const float* gain, int K, int N, bf16_t* WT, LAS float* scr, int item, int lane) {
    const int nblk = N / 32, kb = item / nblk, nb = item % nblk, k0 = 64 * kb, n0 = 32 * nb;
#pragma unroll
    for (int i = 0; i < 32; ++i) { const int kk = 2 * i + (lane >> 5); scr[kk * 33 + (lane & 31)] = W[(size_t)(k0 + kk) * N + n0 + (lane & 31)] * (gain ? gain[k0 + kk] : 1.0f); }
    asm volatile("s_waitcnt lgkmcnt(0)" ::: "memory");
    const int c = lane & 7;
#pragma unroll
    for (int j = 0; j < 4; ++j) { const int n = (lane >> 3) + 8 * j; const LAS float* s = scr + (8 * c) * 33 + n;
        u32x4 o; o.x = pk_bf16(s[0 * 33], s[1 * 33]); o.y = pk_bf16(s[2 * 33], s[3 * 33]); o.z = pk_bf16(s[4 * 33], s[5 * 33]); o.w = pk_bf16(s[6 * 33], s[7 * 33]);
        *(u32x4*)(WT + (size_t)(n0 + n) * K + k0 + 8 * c) = o; }
    asm volatile("s_waitcnt lgkmcnt(0)" ::: "memory");
}

__device__ __forceinline__ void ssm_weights_group(PArg P, LAS unsigned char* lds, int g, int c0, int nc) {
    const int tid = threadIdx.x;
    LAS double* zr = (LAS double*)lds;
    LAS double* zi = zr + 64;
    LAS double* cfr = zi + 64;
    LAS double* cfi = cfr + 64;
    LAS float* apw = (LAS float*)(cfi + 64);
    LAS float* bb = apw + 33 * 64 * 2;
    LAS float* cc = bb + 64 * 16 * 2;
    LAS float* kt = cc + 128;
    const float* lre = P.in(I_LRE); const float* lim = P.in(I_LIM); const float* ldt = P.in(I_LDT);
    if (tid < 64) {
        const int p = tid; const double lr = lre[g * 64 + p], li = lim[g * 64 + p], dt = exp((double)ldt[g]);
        const double a = lr * dt, b = li * dt, er = exp(a), ar = er * cos(b), ai = er * sin(b);
        const double nr = ar - 1.0, ni = ai, den = lr * lr + li * li;
        zr[p] = a; zi[p] = b; cfr[p] = (nr * lr + ni * li) / den; cfi[p] = (ni * lr - nr * li) / den;
    }
    __syncthreads();
    for (int e = tid; e < 33 * 64; e += NTHR) { const int tau = e >> 6, p = e & 63; const double er = exp(zr[p] * tau), an = zi[p] * tau; apw[2 * e] = (float)(er * cos(an)); apw[2 * e + 1] = (float)(er * sin(an)); }
    for (int e = tid; e < 64 * 16; e += NTHR) { const int p = e >> 4; const double br = P.in(I_BRE)[(size_t)(g * 64) * 16 + e], bi = P.in(I_BIM)[(size_t)(g * 64) * 16 + e];
        bb[2 * e] = (float)(cfr[p] * br - cfi[p] * bi); bb[2 * e + 1] = (float)(cfr[p] * bi + cfi[p] * br); }
    for (int c = c0; c < c0 + nc; ++c) {
    if (tid < 64) { cc[2 * tid] = P.in(I_CRE)[(size_t)(g * 16 + c) * 64 + tid]; cc[2 * tid + 1] = P.in(I_CIM)[(size_t)(g * 16 + c) * 64 + tid]; }
    __syncthreads();
    {
        const int tau = tid >> 4, cp = tid & 15; float s = 0.f;
        for (int p = 0; p < 64; ++p) { const float cr = cc[2 * p], ci = cc[2 * p + 1], ar = apw[2 * (tau * 64 + p)], ai = apw[2 * (tau * 64 + p) + 1];
            const float pr = cr * ar - ci * ai, pi = cr * ai + ci * ar; s += pr * bb[2 * (p * 16 + cp)] - pi * bb[2 * (p * 16 + cp) + 1]; }
        kt[tid] = s;
    }
    __syncthreads();
    bf16_t* W2 = (bf16_t*)(P.ws() + WS_WS2) + (size_t)g * 512 * APK;
    for (int e = tid; e < 32 * (APK / 2); e += NTHR) {
        const int i = e / (APK / 2), k = 2 * (e % (APK / 2)); float v[2];
#pragma unroll
        for (int d = 0; d < 2; ++d) { const int kk = k + d;
            if (kk < 128) { const int ri = kk >> 6, p = kk & 63; const float cr = cc[2 * p], ci = cc[2 * p + 1], ar = apw[2 * ((i + 1) * 64 + p)], ai = apw[2 * ((i + 1) * 64 + p) + 1];
                v[d] = ri == 0 ? (cr * ar - ci * ai) : -(cr * ai + ci * ar); }
            else { const int ip = (kk - 128) >> 4, cp = kk & 15, tau = i - ip; v[d] = tau >= 0 ? kt[tau * 16 + cp] : 0.f; } }
        *(unsigned*)(W2 + (size_t)(i * 16 + c) * APK + k) = pk_bf16(v[0], v[1]);
    }
    bf16_t* W1 = (bf16_t*)(P.ws() + WS_WS1) + (size_t)g * 256 * 512;
    for (int e = tid; e < 16 * 256; e += NTHR) {
        const int r = c * 16 + (e >> 8), k = 2 * (e & 255); float v[2] = {0.f, 0.f};
        if (r < 128) { const int ri = r >> 6, p = r & 63;
#pragma unroll
            for (int d = 0; d < 2; ++d) { const int kk = k + d, ip = kk >> 4, cp = kk & 15; const float ar = apw[2 * ((31 - ip) * 64 + p)], ai = apw[2 * ((31 - ip) * 64 + p) + 1], br = bb[2 * (p * 16 + cp)], bi = bb[2 * (p * 16 + cp) + 1];
                v[d] = ri == 0 ? (ar * br - ai * bi) : (ar * bi + ai * br); } }
        *(unsigned*)(W1 + (size_t)r * 512 + k) = pk_bf16(v[0], v[1]);
    }
    if (c == 0 && tid < 64) { float* al = (float*)(P.ws() + WS_AL) + (size_t)(g * 64 + tid) * 2; al[0] = apw[2 * (32 * 64 + tid)]; al[1] = apw[2 * (32 * 64 + tid) + 1]; }
    __syncthreads();
    }
}

__device__ __forceinline__ void phase_prep(PArg P, LAS unsigned char* lds, int part, int w0) {
    const int tid = threadIdx.x, lane = tid & 63, wave = __builtin_amdgcn_readfirstlane(tid >> 6), G = gridDim.x;
    unsigned char* ws = P.ws();
    if (part & 1) {
        if (G * 2 == NG * GC) ssm_weights_group(P, lds, blockIdx.x >> 3, 2 * (blockIdx.x & 7), 2);
        else for (int job = blockIdx.x; job < NG * GC; job += G) ssm_weights_group(P, lds, job >> 4, job & 15, 1);
    }
    if (!(part & 2) || wave < w0) return;
    LAS float* scr = (LAS float*)(lds + wave * 16384);
    const int gw = blockIdx.x * (NWAVES - w0) + (wave - w0), NGW = G * (NWAVES - w0);
    struct TJ { int idx, K, N; size_t off; int gi; };
    const TJ tj[9] = {{I_WIN, 1024, 4096, WS_WIN, I_GPRE}, {I_W1, 1024, 4096, WS_W1, I_GPREMLP}, {I_W2, 4096, 1024, WS_W2, -1}, {I_WOUT, 1024, 1024, WS_WOUT, -1}, {I_WPG, 1024, 1024, WS_WPG, -1},
                      {I_WA, 512, 1024, WS_WA, -1}, {I_WB, 512, 1024, WS_WB, -1}, {I_WGLU, 512, 512, WS_WGLU, -1}, {I_WPLE, 256, 1024, WS_WPLE, -1}};
    int base = 0;
#pragma unroll
    for (int j = 0; j < 9; ++j) { const int items = (tj[j].K / 64) * (tj[j].N / 32);
        const float* gain = tj[j].gi >= 0 ? P.in(tj[j].gi) : nullptr;
        for (int it = (gw + NGW - base % NGW) % NGW; it < items; it += NGW) transpose_item(P.in(tj[j].idx), gain, tj[j].K, tj[j].N, (bf16_t*)(ws + tj[j].off), scr, it, lane);
        base += items; }
}

namespace att {
constexpr int L_K = 0, L_V = 16384, L_KM = 32768, L_WS = 36864, L_OST = 38912, L_END = L_OST + 8 * 4096;
#ifndef MK_THR
#define MK_THR 8.0f
#endif
constexpr float NEG = -1e30f, THR = MK_THR;
__device__ __forceinline__ int crow(int r, int hi) { return (r & 3) + 8 * (r >> 2) + 4 * hi; }
__device__ __forceinline__ s16x4 vtr(const LAS unsigned char* p) { typedef short v4i16_t __attribute__((ext_vector_type(4))); return __builtin_bit_cast(s16x4, __builtin_amdgcn_ds_read_tr16_b64_v4i16((LAS v4i16_t*)p)); }

template <int AV>
__device__ __forceinline__ void attn_phase(PArg P, LAS unsigned char* lds) {
    const int tid = threadIdx.x, lane = tid & 63, wid = __builtin_amdgcn_readfirstlane(tid >> 6), r32 = lane & 31, hi = lane >> 5;
    const bf16_t* Q = (const bf16_t*)(P.ws() + WS_Q); const bf16_t* Kb = (const bf16_t*)(P.ws() + WS_K); const bf16_t* Vb = (const bf16_t*)(P.ws() + WS_V);
    const float* kmean = (const float*)(P.ws() + WS_KMEAN); bf16_t* O = (bf16_t*)(P.ws() + WS_ATT);
    LAS float* wsf = (LAS float*)(lds + L_WS) + wid * 64;
    const int srow = tid >> 3, sch = tid & 7;
    const int kst = srow * 128 + ((sch ^ ((srow >> 1) & 7)) << 4), vst = srow * 128 + ((sch ^ (((srow >> 1) & 1) << 2)) << 4);
    const int kswz = (r32 >> 1) & 7;
    int kfo[4];
#pragma unroll
    for (int ks = 0; ks < 4; ++ks) kfo[ks] = r32 * 128 + (((2 * ks + hi) ^ kswz) << 4);
    const int q4 = (lane & 15) >> 2, p4 = lane & 3, blk = (lane >> 4) & 1, vswz = ((q4 >> 1) & 1) << 2, cl = 2 * blk + (p4 >> 1);
    const int vrow = (4 * hi + q4) * 128 + 8 * (p4 & 1);
    const int vo0 = vrow + ((vswz + cl) << 4), vo1 = vrow + (((4 ^ vswz) + cl) << 4);
    for (int bh = blockIdx.x; bh < BATCH * NHEAD; bh += gridDim.x) {
        const int b = bh >> 3, h = bh & 7;
        __syncthreads();
        if (tid < 256) {
            const int row = tid >> 3, ch = tid & 7; u32x4 w = (u32x4){0u, 0u, 0u, 0u};
            if (row < 16) { const float* km = kmean + (size_t)(b * NBLK + (row & 7)) * ATT_W + h * HD + ch * 8; float v[8];
#pragma unroll
                for (int j = 0; j < 8; ++j) { const float x = km[j] + km[(size_t)NM_PANELS * 512 + j], xh = bf_round(x); v[j] = (row < 8) ? xh : (x - xh); }
                w.x = pk_bf16(v[0], v[1]); w.y = pk_bf16(v[2], v[3]); w.z = pk_bf16(v[4], v[5]); w.w = pk_bf16(v[6], v[7]); }
            *(LAS u32x4*)(lds + L_KM + row * 128 + ((ch ^ ((row >> 1) & 7)) << 4)) = w;
        }
        __syncthreads();
        const bf16_t* Kh = Kb + (size_t)b * SEQ * ATT_W + h * HD; const bf16_t* Vh = Vb + (size_t)b * SEQ * ATT_W + h * HD;
        for (int jb = 0; jb < NBLK; ++jb) {
            const int q0 = jb * MBLK + wid * 32;
            const bf16_t* Qrow = Q + ((size_t)(b * SEQ + q0 + r32)) * ATT_W + h * HD;
            bf16x8 qr[4];
#pragma unroll
            for (int ks = 0; ks < 4; ++ks) qr[ks] = *(const bf16x8*)(Qrow + 16 * ks + 8 * hi);
            unsigned sel = 0;
            {
                f32x16 gz;
#pragma unroll
                for (int r = 0; r < 16; ++r) gz[r] = 0.f;
#pragma unroll
                for (int ks = 0; ks < 4; ++ks) { const bf16x8 kf = *(const LAS bf16x8*)(lds + L_KM + kfo[ks]); gz = __builtin_amdgcn_mfma_f32_32x32x16_bf16(kf, qr[ks], gz, 0, 0, 0); }
                float gate[8];
#pragma unroll
                for (int r = 0; r < 4; ++r) { const float mine = gz[r] + gz[r + 4], oth = __shfl_xor(mine, 32); gate[r] = hi ? oth : mine; gate[r + 4] = hi ? mine : oth; }
#pragma unroll
                for (int it = 0; it < 3; ++it) { int best = -1; float bv = 0.f;
#pragma unroll
                    for (int n = 0; n < 8; ++n) { const bool ok = (n < jb) && !((sel >> n) & 1u); if (ok && (best < 0 || gate[n] > bv)) { best = n; bv = gate[n]; } }
                    if (best >= 0) sel |= 1u << best; }
            }
            const int NT = 4 * (jb + 1);
            float mref, lsum, cbias; bool started;
            f32x16 o0, o1, biasv;
            bool robust = false;
            for (;;) {
            mref = 0.f; lsum = 0.f; cbias = 0.f; started = false;
#pragma unroll
            for (int r = 0; r < 16; ++r) { o0[r] = 0.f; o1[r] = 0.f; biasv[r] = 0.f; }
            u32x4 kA, vA, kB, vB;
#define ATT_LD(kr, vr, tt) do { kr = *(const u32x4*)(Kh + (size_t)((tt) * 64 + srow) * ATT_W + sch * 8); vr = *(const u32x4*)(Vh + (size_t)((tt) * 64 + srow) * ATT_W + sch * 8); } while (0)
#define ATT_ST(kr, vr, bufo) do { *(LAS u32x4*)(lds + L_K + (bufo) + kst) = kr; *(LAS u32x4*)(lds + L_V + (bufo) + vst) = vr; } while (0)
            ATT_LD(kA, vA, 0); ATT_LD(kB, vB, 1);
            ATT_ST(kA, vA, 0);
            __syncthreads();
#define ATT_TILE(t, buf) do { \
                const int nb = (t) >> 2, to = (t) & 3; const bool own = (nb == jb); \
                const bool lane_sel = own || ((sel >> nb) & 1u); \
                const bool active = own ? (to <= (wid >> 1)) : (__any(lane_sel) != 0); \
                if (active) { \
                    const float bias = lane_sel ? -mref : NEG; \
                    if (__any(bias != cbias)) { cbias = bias; _Pragma("unroll") for (int r = 0; r < 16; ++r) biasv[r] = bias; } \
                    f32x16 p0, p1; \
                    const LAS unsigned char* kb_ = lds + L_K + (buf); \
                    if (AV == 4) { p0 = biasv; p1 = biasv; asm volatile("" : "+v"(p0), "+v"(p1)); } else { \
                    { const bf16x8 k0 = *(const LAS bf16x8*)(kb_ + kfo[0]), k1 = *(const LAS bf16x8*)(kb_ + 4096 + kfo[0]); \
                      p0 = __builtin_amdgcn_mfma_f32_32x32x16_bf16(k0, qr[0], biasv, 0, 0, 0); p1 = __builtin_amdgcn_mfma_f32_32x32x16_bf16(k1, qr[0], biasv, 0, 0, 0); } \
                    _Pragma("unroll") for (int ks = 1; ks < 4; ++ks) { \
                        const bf16x8 k0 = *(const LAS bf16x8*)(kb_ + kfo[ks]), k1 = *(const LAS bf16x8*)(kb_ + 4096 + kfo[ks]); \
                        p0 = __builtin_amdgcn_mfma_f32_32x32x16_bf16(k0, qr[ks], p0, 0, 0, 0); p1 = __builtin_amdgcn_mfma_f32_32x32x16_bf16(k1, qr[ks], p1, 0, 0, 0); } } \
                      \
                    const LAS unsigned char* vb_ = lds + L_V + (buf); \
                    bf16x8 vfa[4], vfb[4]; \
                    if (AV != 2) { _Pragma("unroll") for (int kk = 0; kk < 4; ++kk) { \
                        const int ro = (32 * (kk >> 1) + 16 * (kk & 1)) * 128; \
                        const s16x4 a0 = vtr(vb_ + ro + vo0), a1 = vtr(vb_ + ro + 8 * 128 + vo0); \
                        const s16x4 c0 = vtr(vb_ + ro + vo1), c1 = vtr(vb_ + ro + 8 * 128 + vo1); \
                        vfa[kk] = __builtin_shufflevector(a0, a1, 0, 1, 2, 3, 4, 5, 6, 7); vfb[kk] = __builtin_shufflevector(c0, c1, 0, 1, 2, 3, 4, 5, 6, 7); } } \
                    if (own && to == (wid >> 1)) { const int ql = (wid & 1) * 32 + r32; \
                        _Pragma("unroll") for (int r = 0; r < 16; ++r) { const int kl = crow(r, hi); if (kl > ql) p0[r] = NEG; if (kl + 32 > ql) p1[r] = NEG; } } \
                    if (robust) { \
                    float mx = fmaxf(p0[0], p1[0]); \
                    _Pragma("unroll") for (int r = 1; r < 16; ++r) mx = fmaxf(fmaxf(mx, p0[r]), p1[r]); \
                    mx = fmaxf(mx, __shfl_xor(mx, 32)); \
                    const bool valid = mx > -1e29f; \
                    const bool need = valid && (!started || mx > THR); \
                    if (__any(need)) { \
                        const float dl = need ? mx : 0.f; \
                        const float f = (need && started) ? __builtin_amdgcn_exp2f(-dl) : 1.0f; \
                        mref += dl; lsum *= f; \
                        _Pragma("unroll") for (int r = 0; r < 16; ++r) { p0[r] -= dl; p1[r] -= dl; } \
                        if (hi == 0) wsf[r32] = f; \
                        asm volatile("s_waitcnt lgkmcnt(0)" ::: "memory"); \
                        _Pragma("unroll") for (int r = 0; r < 16; ++r) { const float fr_ = wsf[crow(r, hi)]; o0[r] *= fr_; o1[r] *= fr_; } \
                    } \
                    started = started || valid; } \
                    float ls = 0.f; \
                    if (AV != 1) { _Pragma("unroll") for (int r = 0; r < 16; ++r) { p0[r] = __builtin_amdgcn_exp2f(p0[r]); p1[r] = __builtin_amdgcn_exp2f(p1[r]); ls += p0[r] + p1[r]; } } \
                    lsum += ls; \
                    bf16x8 pa[4]; \
                    _Pragma("unroll") for (int s2 = 0; s2 < 2; ++s2) { u32x4 w0, w1; \
                        w0.x = pk_bf16(p0[8 * s2 + 0], p0[8 * s2 + 1]); w0.y = pk_bf16(p0[8 * s2 + 2], p0[8 * s2 + 3]); w0.z = pk_bf16(p0[8 * s2 + 4], p0[8 * s2 + 5]); w0.w = pk_bf16(p0[8 * s2 + 6], p0[8 * s2 + 7]); \
                        w1.x = pk_bf16(p1[8 * s2 + 0], p1[8 * s2 + 1]); w1.y = pk_bf16(p1[8 * s2 + 2], p1[8 * s2 + 3]); w1.z = pk_bf16(p1[8 * s2 + 4], p1[8 * s2 + 5]); w1.w = pk_bf16(p1[8 * s2 + 6], p1[8 * s2 + 7]); \
                        pa[s2] = __builtin_bit_cast(bf16x8, w0); pa[2 + s2] = __builtin_bit_cast(bf16x8, w1); } \
                    if (AV == 2) { asm volatile("" :: "v"(pa[0]), "v"(pa[1]), "v"(pa[2]), "v"(pa[3])); } else \
                    _Pragma("unroll") for (int kk = 0; kk < 4; ++kk) { \
                        o0 = __builtin_amdgcn_mfma_f32_32x32x16_bf16(pa[kk], vfa[kk], o0, 0, 0, 0); \
                        o1 = __builtin_amdgcn_mfma_f32_32x32x16_bf16(pa[kk], vfb[kk], o1, 0, 0, 0); } \
                } } while (0)
            for (int t = 0; t < NT; t += 2) {
                if (AV != 3) { if (t + 2 < NT) ATT_LD(kA, vA, t + 2); }
                ATT_TILE(t, 0);
                if (AV != 3) { ATT_ST(kB, vB, 8192);
                __syncthreads();
                if (t + 3 < NT) ATT_LD(kB, vB, t + 3); }
                ATT_TILE(t + 1, 8192);
                if (AV != 3) { if (t + 2 < NT) ATT_ST(kA, vA, 0);
                __syncthreads(); }
            }
            lsum += __shfl_xor(lsum, 32);
            if (robust || AV != 0) break;
            {
#if defined(MK_FORCE_ROBUST)
                const bool bad = true;
#else
                const bool bad = !(lsum > 1e-30f && lsum < 1e30f);
#endif
                LAS unsigned* fl = (LAS unsigned*)(lds + L_END);
                const unsigned wb = __any(bad) ? 1u : 0u;
                if (lane == 0) fl[wid] = wb;
                __syncthreads();
                unsigned anyb = 0;
#pragma unroll
                for (int w8 = 0; w8 < 8; ++w8) anyb |= fl[w8];
                __syncthreads();
                if (!anyb) break;
                robust = true;
            }
            }
#undef ATT_LD
#undef ATT_ST
#undef ATT_TILE
            if (hi == 0) wsf[32 + r32] = lsum;
            asm volatile("s_waitcnt lgkmcnt(0)" ::: "memory");
            LAS bf16_t* stg = (LAS bf16_t*)(lds + L_OST) + wid * 2048;
#pragma unroll
            for (int r = 0; r < 16; ++r) { const int orow = crow(r, hi); const float rl = __builtin_amdgcn_rcpf(wsf[32 + orow]);
                stg[orow * 64 + r32] = (bf16_t)(pk_bf16(o0[r] * rl, 0.f) & 0xffffu); stg[orow * 64 + 32 + r32] = (bf16_t)(pk_bf16(o1[r] * rl, 0.f) & 0xffffu); }
            asm volatile("s_waitcnt lgkmcnt(0)" ::: "memory");
            if (AV != 0) { asm volatile("" :: "v"(o0), "v"(o1), "v"(lsum)); continue; }
            bf16_t* Ow = O + ((size_t)(b * SEQ + q0)) * ATT_W + h * HD;
#pragma unroll
            for (int i = 0; i < 4; ++i) { const int row = i * 8 + (lane >> 3), ch = lane & 7; const u32x4 v = *(const LAS u32x4*)(stg + row * 64 + ch * 8); *(u32x4*)(Ow + (size_t)row * ATT_W + ch * 8) = v; }
        }
    }
}
}


#ifndef MK_ATT2
#define MK_ATT2 1
#endif
#ifndef MK_THRL
#define MK_THRL 8
#endif
namespace att2 {
constexpr int NSLOT = 3, SLOTB = 8192;
constexpr int L_K = 0, L_V = NSLOT * SLOTB, L_WS = 2 * NSLOT * SLOTB, L_OST = L_WS + 8 * 64 * 4, L_KM = L_OST + 8 * 4096, L_END = L_KM + 4096;
constexpr float NEGB = -1e30f;
__device__ __forceinline__ int crow(int r, int hi) { return (r & 3) + 8 * (r >> 2) + 4 * hi; }
#define SBAR() __builtin_amdgcn_sched_barrier(0)
#define WAIT_BAR(N) asm volatile("s_waitcnt vmcnt(" #N ") lgkmcnt(0)\n\ts_barrier" ::: "memory")
__device__ __forceinline__ void glds16(const void* gsrc, unsigned lds_dst) { unsigned keep;
    asm volatile("s_mov_b32 %0, m0\n\ts_mov_b32 m0, %2\n\ts_nop 0\n\tglobal_load_lds_dwordx4 %1, off\n\ts_mov_b32 m0, %0" : "=&s"(keep) : "v"(gsrc), "s"(lds_dst) : "memory"); }
__device__ __forceinline__ float max3f(float a, float b, float c) { float r; asm("v_max3_f32 %0, %1, %2, %3" : "=v"(r) : "v"(a), "v"(b), "v"(c)); return r; }
__device__ __forceinline__ float max2f(float a, float b) { float r; asm("v_max_f32_e32 %0, %1, %2" : "=v"(r) : "v"(a), "v"(b)); return r; }
__device__ __forceinline__ float fadd_s(float a, float b) { float r; asm("v_add_f32_e32 %0, %1, %2" : "=v"(r) : "v"(a), "v"(b)); return r; }
__device__ __forceinline__ float fsub_s(float a, float b) { float r; asm("v_sub_f32_e32 %0, %1, %2" : "=v"(r) : "v"(a), "v"(b)); return r; }
__device__ __forceinline__ unsigned cvtpk_s(float lo, float hi) { f32x2_t v = {lo, hi}; bf16x2_t b = __builtin_convertvector(v, bf16x2_t); return __builtin_bit_cast(unsigned, b); }
typedef const LAS unsigned char* lds_cptr;
typedef short v4i16_t __attribute__((ext_vector_type(4)));
__device__ __forceinline__ void cmask(f32x16& p0, f32x16& p1, int jb, int qrel, int hi) {
    const float NEG = -INFINITY; const int kb = 64 * jb + 4 * hi;
#pragma unroll
    for (int r = 0; r < 16; ++r) { const int kv = kb + (r & 3) + 8 * (r >> 2); if (kv > qrel) p0[r] = NEG; if (kv + 32 > qrel) p1[r] = NEG; }
}
__device__ __forceinline__ void qkt(f32x16& p0, f32x16& p1, lds_cptr kb, const bf16x8* qr, const f32x16& negm) {
#pragma unroll
    for (int d0 = 0; d0 < 4; ++d0) {
        const bf16x8 b0 = *(const LAS bf16x8*)(kb + d0 * 2048);
        const bf16x8 b1 = *(const LAS bf16x8*)(kb + d0 * 2048 + 512);
        if (d0 == 0) { p0 = __builtin_amdgcn_mfma_f32_32x32x16_bf16(b0, qr[0], negm, 0, 0, 0); p1 = __builtin_amdgcn_mfma_f32_32x32x16_bf16(b1, qr[0], negm, 0, 0, 0); }
        else { p0 = __builtin_amdgcn_mfma_f32_32x32x16_bf16(b0, qr[d0], p0, 0, 0, 0); p1 = __builtin_amdgcn_mfma_f32_32x32x16_bf16(b1, qr[d0], p1, 0, 0, 0); } }
}
__device__ __forceinline__ void kload8(bf16x8* kf, lds_cptr kp) {
    kf[0] = *(const LAS bf16x8*)(kp);        kf[1] = *(const LAS bf16x8*)(kp + 512);
    kf[2] = *(const LAS bf16x8*)(kp + 2048); kf[3] = *(const LAS bf16x8*)(kp + 2560);
    kf[4] = *(const LAS bf16x8*)(kp + 4096); kf[5] = *(const LAS bf16x8*)(kp + 4608);
    kf[6] = *(const LAS bf16x8*)(kp + 6144); kf[7] = *(const LAS bf16x8*)(kp + 6656);
}
__device__ __forceinline__ void kload2(bf16x8* kf, lds_cptr kp, int j) { kf[2 * j] = *(const LAS bf16x8*)(kp + j * 2048); kf[2 * j + 1] = *(const LAS bf16x8*)(kp + j * 2048 + 512); }
__device__ __forceinline__ s16x4 vtr(lds_cptr p) { return __builtin_bit_cast(s16x4, __builtin_amdgcn_ds_read_tr16_b64_v4i16((LAS v4i16_t*)p)); }
__device__ __forceinline__ float rowmax(const f32x16& p0, const f32x16& p1) {
    float a = max3f(p0[0], p0[1], p1[0]), b = max3f(p0[2], p0[3], p1[1]); a = max3f(a, p1[2], p1[3]);
#pragma unroll
    for (int r = 4; r < 16; r += 4) { a = max3f(a, p0[r], p0[r + 1]); b = max3f(b, p0[r + 2], p0[r + 3]); a = max3f(a, p1[r], p1[r + 1]); b = max3f(b, p1[r + 2], p1[r + 3]); }
    const float m = max2f(a, b);
    auto rr = __builtin_amdgcn_permlane32_swap(__float_as_uint(m), __float_as_uint(m), false, false);
    return max2f(__uint_as_float(rr[0]), __uint_as_float(rr[1]));
}
__device__ __forceinline__ void pv(f32x16* o, int vb, bf16x8 pa0, bf16x8 pa1, bf16x8 pa2, bf16x8 pa3) {
#pragma unroll
    for (int d0 = 0; d0 < 2; ++d0) { s16x4 lo[4], hi[4];
#pragma unroll
        for (int ks = 0; ks < 4; ++ks) {
            asm volatile("ds_read_b64_tr_b16 %0,%1 offset:%c2" : "=&v"(lo[ks]) : "v"(vb), "i"(d0 * 4096 + ks * 1024) : "memory");
            asm volatile("ds_read_b64_tr_b16 %0,%1 offset:%c2" : "=&v"(hi[ks]) : "v"(vb), "i"(d0 * 4096 + ks * 1024 + 512) : "memory"); }
        asm volatile("s_waitcnt lgkmcnt(0)" ::: "memory"); SBAR();
#define PK(k) (bf16x8){lo[k][0], lo[k][1], lo[k][2], lo[k][3], hi[k][0], hi[k][1], hi[k][2], hi[k][3]}
        o[d0] = __builtin_amdgcn_mfma_f32_32x32x16_bf16(pa0, PK(0), o[d0], 0, 0, 0);
        o[d0] = __builtin_amdgcn_mfma_f32_32x32x16_bf16(pa1, PK(1), o[d0], 0, 0, 0);
        o[d0] = __builtin_amdgcn_mfma_f32_32x32x16_bf16(pa2, PK(2), o[d0], 0, 0, 0);
        o[d0] = __builtin_amdgcn_mfma_f32_32x32x16_bf16(pa3, PK(3), o[d0], 0, 0, 0);
#undef PK
    }
}

template <int THRL, int PM>
__device__ __forceinline__ void attn_phase(PArg P, LAS unsigned char* lds) {
    const int tid = threadIdx.x; const int wid = __builtin_amdgcn_readfirstlane(tid >> 6);
    const bf16_t* Q = (const bf16_t*)(P.ws() + WS_Q); const bf16_t* Kb = (const bf16_t*)(P.ws() + WS_K); const bf16_t* Vb = (const bf16_t*)(P.ws() + WS_V);
    const float* kmean = (const float*)(P.ws() + WS_KMEAN); bf16_t* O = (bf16_t*)(P.ws() + WS_ATT);
    LAS float* wsf = (LAS float*)(lds + L_WS) + wid * 64;
    const unsigned lds0 = (unsigned)(uintptr_t)lds;
    const unsigned kdst = lds0 + L_K + wid * 1024, vdst = lds0 + L_V + wid * 1024;
    for (int bh = blockIdx.x; bh < BATCH * NHEAD; bh += gridDim.x) {
        const int b = bh >> 3, h = bh & 7;
        __syncthreads();
        if (tid < 256) {
            const int row = tid >> 3, ch = tid & 7; u32x4 w = (u32x4){0u, 0u, 0u, 0u};
            if (row < 16) { const float* km = kmean + (size_t)(b * NBLK + (row & 7)) * ATT_W + h * HD + ch * 8; float v[8];
#pragma unroll
                for (int j = 0; j < 8; ++j) { const float x = km[j] + km[(size_t)NM_PANELS * 512 + j], xh = bf_round(x); v[j] = (row < 8) ? xh : (x - xh); }
                w.x = pk_bf16(v[0], v[1]); w.y = pk_bf16(v[2], v[3]); w.z = pk_bf16(v[4], v[5]); w.w = pk_bf16(v[6], v[7]); }
            *(LAS u32x4*)(lds + L_KM + row * 128 + ((ch ^ ((row >> 1) & 7)) << 4)) = w;
        }
        __syncthreads();
        const int bk = (PM == 2) ? 0 : b, hk = (PM == 2) ? 0 : h;
        const bf16_t* Kh = Kb + (size_t)bk * SEQ * ATT_W + hk * HD; const bf16_t* Vh = Vb + (size_t)bk * SEQ * ATT_W + hk * HD;
#define DMA_K(t, slot) glds16(ksrc + (size_t)(t) * 64 * ATT_W, (unsigned)__builtin_amdgcn_readfirstlane(kdst + (slot)))
#define DMA_V(t, slot) glds16(vsrc + (size_t)(t) * 64 * ATT_W, (unsigned)__builtin_amdgcn_readfirstlane(vdst + (slot)))
#define NXT(x) (((x) == (NSLOT - 1) * SLOTB) ? 0 : (x) + SLOTB)
        int ring0 = 0;
        bf16x8 qr[4];
        {
            int tido = tid; asm volatile("" : "+v"(tido));
            const int lane = tido & 63, r32 = lane & 31, hi = lane >> 5;
            const bf16_t* ksrc = Kh + (size_t)lane * ATT_W + wid * 8;
            const bf16_t* vsrc = Vh + (size_t)(16 * (wid & 3) + (lane >> 2)) * ATT_W + (wid >> 2) * 32 + (lane & 3) * 8;
            const bf16_t* Qw = Q + ((size_t)(b * SEQ + wid * 32)) * ATT_W + h * HD;
            DMA_K(0, 0); DMA_V(0, 0); DMA_K(1, SLOTB);
#pragma unroll
            for (int d0 = 0; d0 < 4; ++d0) qr[d0] = *(const bf16x8*)(Qw + (size_t)r32 * ATT_W + d0 * 16 + hi * 8);
            DMA_K(2, 2 * SLOTB);
        }
        for (int jb = 0; jb < NBLK; ++jb) {
            int jbo = jb; asm volatile("" : "+s"(jbo));
            int tido = tid; asm volatile("" : "+v"(tido));
            const int lane = tido & 63, r32 = lane & 31, hi = lane >> 5;
            const int vb0 = (int)(lds0 + L_V) + ((lane >> 4) & 1) * 32 + (lane & 3) * 8 + (4 * hi + ((lane & 15) >> 2)) * 64;
            const lds_cptr kp0 = lds + L_K + hi * 1024 + r32 * 16;
            const lds_cptr vp0 = lds + L_V + ((lane >> 4) & 1) * 32 + (lane & 3) * 8 + (4 * hi + ((lane & 15) >> 2)) * 64;
            const int qrel = wid * 32 + r32;
            const bf16_t* ksrc = Kh + (size_t)lane * ATT_W + wid * 8;
            const bf16_t* vsrc = Vh + (size_t)(16 * (wid & 3) + (lane >> 2)) * ATT_W + (wid >> 2) * 32 + (lane & 3) * 8;
            const int q0 = jbo * MBLK;
            const bf16_t* Qw = Q + ((size_t)(b * SEQ + q0 + wid * 32)) * ATT_W + h * HD;
            const int NT = (PM == 1) ? 4 : 4 * (jbo + 1);
            unsigned sel = 0;
            {
                const int kswz = (r32 >> 1) & 7;
                f32x16 gz;
#pragma unroll
                for (int r = 0; r < 16; ++r) gz[r] = 0.f;
#pragma unroll
                for (int ks = 0; ks < 4; ++ks) { const bf16x8 kf_ = *(const LAS bf16x8*)(lds + L_KM + r32 * 128 + (((2 * ks + hi) ^ kswz) << 4)); gz = __builtin_amdgcn_mfma_f32_32x32x16_bf16(kf_, qr[ks], gz, 0, 0, 0); }
                float gate[8];
#pragma unroll
                for (int r = 0; r < 4; ++r) { const float mine = gz[r] + gz[r + 4], oth = __shfl_xor(mine, 32); gate[r] = hi ? oth : mine; gate[r + 4] = hi ? mine : oth; }
#pragma unroll
                for (int it = 0; it < 3; ++it) { int best = -1; float bv = 0.f;
#pragma unroll
                    for (int n = 0; n < 8; ++n) { const bool ok = (n < jbo) && !((sel >> n) & 1u); if (ok && (best < 0 || gate[n] > bv)) { best = n; bv = gate[n]; } }
                    if (best >= 0) sel |= 1u << best; }
                sel |= (PM == 1) ? 1u : (1u << jbo);
            }
            bf16x8 kf[8];
            float mhat = 0.f, l_reg = 0.f; f32x16 o[2]; f32x16 negm; bool started = false;
#pragma unroll
            for (int r = 0; r < 16; ++r) { o[0][r] = 0.f; o[1][r] = 0.f; }
            { const float nb_ = (sel & 1u) ? 0.f : NEGB;
#pragma unroll
              for (int r = 0; r < 16; ++r) negm[r] = nb_; }
            asm volatile("" : "+v"(negm));
#define CMASK(P0, P1, t) do { int jb_ = (t) - (NT - 4); if (jb_ >= 0) cmask(P0, P1, jb_, qrel, hi); } while (0)
#define SETNEGM(tn) do { const float nb_ = ((sel >> ((tn) >> 2)) & 1u) ? -mhat : NEGB; _Pragma("unroll") for (int r = 0; r < 16; ++r) negm[r] = nb_; asm volatile("" : "+v"(negm)); } while (0)
            bool resc = false;
#define START(P0, P1) do { const float rm = rowmax(P0, P1); resc = false; \
                { const bool valid_ = rm > -1e29f; const float dl = valid_ ? rm : 0.f; started = valid_; mhat = fadd_s(mhat, dl); \
                  _Pragma("unroll") for (int r = 0; r < 16; ++r) { P0[r] = fsub_s(P0[r], dl); P1[r] = fsub_s(P1[r], dl); } \
                  SETNEGM(1); } \
                _Pragma("unroll") for (int r = 0; r < 16; ++r) P0[r] = __builtin_amdgcn_exp2f(P0[r]); } while (0)
#define RESC() do { if (resc) { asm volatile("s_waitcnt lgkmcnt(0)" ::: "memory"); \
                _Pragma("unroll") for (int d_ = 0; d_ < 2; ++d_) _Pragma("unroll") for (int r = 0; r < 16; ++r) o[d_][r] *= wsf[crow(r, hi)]; } } while (0)
            f32x16 pA0, pA1, pB0, pB1;
            int sl_prev = ring0, sl_cur = ring0, sl_next = NXT(ring0);
#define ROT() do { sl_prev = sl_cur; sl_cur = sl_next; sl_next = NXT(sl_next); } while (0)
            WAIT_BAR(3);
            qkt(pA0, pA1, kp0 + sl_cur, qr, negm); asm volatile("s_nop 15\n\ts_nop 7" : "+v"(pA0), "+v"(pA1)); CMASK(pA0, pA1, 0);
            START(pA0, pA1);
#pragma unroll
            for (int r = 0; r < 16; ++r) pA1[r] = __builtin_amdgcn_exp2f(pA1[r]);
            WAIT_BAR(0);
            DMA_K(3, sl_cur); DMA_V(1, sl_next);
            ROT();
            kload8(kf, kp0 + sl_cur);
            WAIT_BAR(2);
            s16x4 vlo[8], vhi[8]; u32x4 pw0, pw1, pw2, pw3;
#define PKW(P, B) cvtpk_s(P[B], P[B + 1])
#define PAF(k) __builtin_bit_cast(bf16x8, pw##k)
#define VFR(i) (bf16x8){vlo[i][0], vlo[i][1], vlo[i][2], vlo[i][3], vhi[i][0], vhi[i][1], vhi[i][2], vhi[i][3]}
#define PIN(x) asm volatile("" : "+v"(x))
#define MX3(a, b, c) __builtin_fmaxf(__builtin_fmaxf((a), (b)), (c))
#define GAPA(MF, A0, A1, A2, A3, W0, W1, PW) do { MF; sacc += A0; sacc += A1; sacc += A2; sacc += A3; PIN(sacc); W0; W1; PIN(PW); SBAR(); } while (0)
#define EX(v) __builtin_amdgcn_exp2f(v)
#define GAPB(MF, X, B) do { MF; X[B] = EX(X[B]); X[B + 1] = EX(X[B + 1]); X[B + 2] = EX(X[B + 2]); X[B + 3] = EX(X[B + 3]); PIN(X); SBAR(); } while (0)
#define VRD(i) do { vlo[i] = vtr(vp_ + (((i) >> 2) * 4096 + ((i) & 3) * 1024)); vhi[i] = vtr(vp_ + (((i) >> 2) * 4096 + ((i) & 3) * 1024 + 512)); } while (0)
#define KRD(G, j) do { if (G) { kload2(kf, kp0 + sl_next, j); SBAR(); } } while (0)
#define STEP(C0, C1, P0, P1, t, GK, GV, GL) do { SBAR(); \
    const lds_cptr vp_ = vp0 + sl_prev; \
    VRD(0); SBAR(); float sacc = (P0[0] + P0[1]); \
    GAPA(C0 = __builtin_amdgcn_mfma_f32_32x32x16_bf16(kf[0], qr[0], negm, 0, 0, 0), P0[2], P0[3], P0[4], P0[5],     pw0[0] = PKW(P0, 0), pw0[1] = PKW(P0, 2), pw0); \
    VRD(4); SBAR(); GAPA(C1 = __builtin_amdgcn_mfma_f32_32x32x16_bf16(kf[1], qr[0], negm, 0, 0, 0), P0[6], P0[7], P0[8], P0[9],     pw0[2] = PKW(P0, 4), pw0[3] = PKW(P0, 6), pw0); \
    VRD(1); SBAR(); GAPA(C0 = __builtin_amdgcn_mfma_f32_32x32x16_bf16(kf[2], qr[1], C0, 0, 0, 0),   P0[10], P0[11], P0[12], P0[13], pw1[0] = PKW(P0, 8), pw1[1] = PKW(P0, 10), pw1); \
    VRD(5); SBAR(); GAPA(C1 = __builtin_amdgcn_mfma_f32_32x32x16_bf16(kf[3], qr[1], C1, 0, 0, 0),   P0[14], P0[15], P1[0], P1[1],   pw1[2] = PKW(P0, 12), pw1[3] = PKW(P0, 14), pw1); \
    VRD(2); SBAR(); GAPA(C0 = __builtin_amdgcn_mfma_f32_32x32x16_bf16(kf[4], qr[2], C0, 0, 0, 0),   P1[2], P1[3], P1[4], P1[5],     pw2[0] = PKW(P1, 0), pw2[1] = PKW(P1, 2), pw2); \
    VRD(6); SBAR(); GAPA(C1 = __builtin_amdgcn_mfma_f32_32x32x16_bf16(kf[5], qr[2], C1, 0, 0, 0),   P1[6], P1[7], P1[8], P1[9],     pw2[2] = PKW(P1, 4), pw2[3] = PKW(P1, 6), pw2); \
    VRD(3); SBAR(); GAPA(C0 = __builtin_amdgcn_mfma_f32_32x32x16_bf16(kf[6], qr[3], C0, 0, 0, 0),   P1[10], P1[11], P1[12], P1[13], pw3[0] = PKW(P1, 8), pw3[1] = PKW(P1, 10), pw3); \
    VRD(7); SBAR(); GAPA(C1 = __builtin_amdgcn_mfma_f32_32x32x16_bf16(kf[7], qr[3], C1, 0, 0, 0),   P1[14], P1[15], 0.f, 0.f,       pw3[2] = PKW(P1, 12), pw3[3] = PKW(P1, 14), pw3); \
    l_reg += sacc; \
    if (GK) { DMA_K((t) + 3, sl_cur); } if (GV) { DMA_V((t) + 1, sl_next); } \
    CMASK(C0, C1, t); \
    { float a = MX3(C0[0], C0[1], C1[0]), b_ = MX3(C0[2], C0[3], C1[1]); a = MX3(a, C1[2], C1[3]); \
      _Pragma("unroll") for (int r = 4; r < 16; r += 4) { a = MX3(a, C0[r], C0[r + 1]); b_ = MX3(b_, C0[r + 2], C0[r + 3]); a = MX3(a, C1[r], C1[r + 1]); b_ = MX3(b_, C1[r + 2], C1[r + 3]); } \
      float rm = __builtin_fmaxf(a, b_); { auto rr = __builtin_amdgcn_permlane32_swap(__float_as_uint(rm), __float_as_uint(rm), false, false); rm = __builtin_fmaxf(__uint_as_float(rr[0]), __uint_as_float(rr[1])); } \
      resc = false; \
      const bool valid_ = rm > -1e29f; const bool need_ = valid_ && (!started || rm > (float)THRL); \
      if (__builtin_expect(__any(need_), 0)) { const float dl = valid_ ? (started ? __builtin_fmaxf(rm, 0.f) : rm) : 0.f; mhat += dl; \
        _Pragma("unroll") for (int r = 0; r < 16; ++r) { C0[r] -= dl; C1[r] -= dl; } \
        const float f = started ? __builtin_amdgcn_exp2f(-dl) : 1.0f; l_reg *= f; if (hi == 0) wsf[r32] = f; resc = true; } \
      started = started || valid_; \
      if (resc || ((((t) + 1) & 3) == 0)) SETNEGM((t) + 1); } \
    SBAR(); \
    GAPB(o[0] = __builtin_amdgcn_mfma_f32_32x32x16_bf16(PAF(0), VFR(0), o[0], 0, 0, 0), C0, 0); \
    GAPB(o[1] = __builtin_amdgcn_mfma_f32_32x32x16_bf16(PAF(0), VFR(4), o[1], 0, 0, 0), C0, 4); \
    KRD(GL, 0); GAPB(o[0] = __builtin_amdgcn_mfma_f32_32x32x16_bf16(PAF(1), VFR(1), o[0], 0, 0, 0), C0, 8); \
    KRD(GL, 1); GAPB(o[1] = __builtin_amdgcn_mfma_f32_32x32x16_bf16(PAF(1), VFR(5), o[1], 0, 0, 0), C0, 12); \
    KRD(GL, 2); GAPB(o[0] = __builtin_amdgcn_mfma_f32_32x32x16_bf16(PAF(2), VFR(2), o[0], 0, 0, 0), C1, 0); \
    KRD(GL, 3); GAPB(o[1] = __builtin_amdgcn_mfma_f32_32x32x16_bf16(PAF(2), VFR(6), o[1], 0, 0, 0), C1, 4); \
    GAPB(o[0] = __builtin_amdgcn_mfma_f32_32x32x16_bf16(PAF(3), VFR(3), o[0], 0, 0, 0), C1, 8); \
    GAPB(o[1] = __builtin_amdgcn_mfma_f32_32x32x16_bf16(PAF(3), VFR(7), o[1], 0, 0, 0), C1, 12); \
    } while (0)
            int t = 1;
#undef CMASK
#define CMASK(P0, P1, t) do { } while (0)
            for (; t + 5 < NT; t += 2) {
                STEP(pB0, pB1, pA0, pA1, t, true, true, true);     WAIT_BAR(2); RESC(); ROT();
                STEP(pA0, pA1, pB0, pB1, t + 1, true, true, true); WAIT_BAR(2); RESC(); ROT();
            }
#undef CMASK
#define CMASK(P0, P1, t) do { int jb_ = (t) - (NT - 4); if (jb_ >= 0) cmask(P0, P1, jb_, qrel, hi); } while (0)
#define ENDW(tt) do { if ((tt) + 3 < NT) { WAIT_BAR(2); } else if ((tt) + 2 < NT) { WAIT_BAR(1); } else { WAIT_BAR(0); } } while (0)
            for (; t + 1 < NT; t += 2) {
                STEP(pB0, pB1, pA0, pA1, t, (t + 3 < NT), (t + 1 < NT), (t + 1 < NT));     ENDW(t);     RESC(); ROT();
                STEP(pA0, pA1, pB0, pB1, t + 1, (t + 4 < NT), (t + 2 < NT), (t + 2 < NT)); ENDW(t + 1); RESC(); ROT();
            }
            const bool more = jbo + 1 < NBLK;
            if (more) { DMA_K(0, sl_next); DMA_V(0, sl_next); DMA_K(1, sl_prev); DMA_K(2, sl_cur); ring0 = sl_next; }
            STEP(pB0, pB1, pA0, pA1, NT - 1, false, false, false); RESC();
            if (more) { const bf16_t* Qn = Qw + (size_t)MBLK * ATT_W;
#pragma unroll
                for (int d0 = 0; d0 < 4; ++d0) qr[d0] = *(const bf16x8*)(Qn + (size_t)r32 * ATT_W + d0 * 16 + hi * 8); }
            { float sacc = pB0[0] + pB0[1];
#pragma unroll
              for (int r = 2; r < 16; ++r) sacc += pB0[r];
#pragma unroll
              for (int r = 0; r < 16; ++r) sacc += pB1[r];
              l_reg += sacc;
              pw0 = (u32x4){PKW(pB0, 0), PKW(pB0, 2), PKW(pB0, 4), PKW(pB0, 6)}; pw1 = (u32x4){PKW(pB0, 8), PKW(pB0, 10), PKW(pB0, 12), PKW(pB0, 14)};
              pw2 = (u32x4){PKW(pB1, 0), PKW(pB1, 2), PKW(pB1, 4), PKW(pB1, 6)}; pw3 = (u32x4){PKW(pB1, 8), PKW(pB1, 10), PKW(pB1, 12), PKW(pB1, 14)};
              SBAR(); pv(o, vb0 + sl_cur, PAF(0), PAF(1), PAF(2), PAF(3)); }
#undef PKW
#undef PAF
#undef VFR
#undef PIN
#undef MX3
#undef GAPA
#undef GAPB
#undef EX
#undef VRD
#undef KRD
#undef STEP
#undef ENDW
            { auto rr = __builtin_amdgcn_permlane32_swap(__float_as_uint(l_reg), __float_as_uint(l_reg), false, false); l_reg = __uint_as_float(rr[0]) + __uint_as_float(rr[1]); }
            if (hi == 0) wsf[32 + r32] = l_reg; asm volatile("s_waitcnt lgkmcnt(0)" ::: "memory");
            bf16_t* Ow = O + ((size_t)(b * SEQ + q0 + wid * 32)) * ATT_W + h * HD;
            { LAS bf16_t* stg = (LAS bf16_t*)(lds + L_OST) + wid * 2048;
#pragma unroll
              for (int r = 0; r < 16; ++r) { const int orow = crow(r, hi); const float rl = __builtin_amdgcn_rcpf(wsf[32 + orow]);
                  stg[orow * 64 + r32] = (bf16_t)(pk_bf16(o[0][r] * rl, 0.f) & 0xffffu); stg[orow * 64 + 32 + r32] = (bf16_t)(pk_bf16(o[1][r] * rl, 0.f) & 0xffffu); }
              asm volatile("s_waitcnt lgkmcnt(0)" ::: "memory");
#pragma unroll
              for (int i = 0; i < 4; ++i) { const int row = i * 8 + (lane >> 3), ch = lane & 7; const u32x4 v = *(const LAS u32x4*)(stg + row * 64 + ch * 8); *(u32x4*)(Ow + (size_t)row * ATT_W + ch * 8) = v; } }
            asm volatile("s_waitcnt lgkmcnt(0)\n\ts_barrier" ::: "memory");
#undef CMASK
#undef SETNEGM
#undef START
#undef RESC
#undef ROT
        }
#undef DMA_K
#undef DMA_V
#undef NXT
    }
}
#undef SBAR
#undef WAIT_BAR
}

#define XB_TMO      128
#define XB_XCNT(j)  (256  + 64 * (j))
#define XB_XSUB(j)  (1280 + 64 * (j))
#define XB_XGEN(j)  (2304 + 64 * (j))
#define XB_TOP      3328
#define XB_TOPGEN   3392
#define XCD_BAR_WORDS 3456
#define XB_SPIN_CAP (1u << 20)
__device__ __forceinline__ unsigned xb_ld(unsigned* p)              { return __hip_atomic_load(p, __ATOMIC_RELAXED, __HIP_MEMORY_SCOPE_AGENT); }
__device__ __forceinline__ unsigned xb_add(unsigned* p, unsigned v) { return __hip_atomic_fetch_add(p, v, __ATOMIC_RELAXED, __HIP_MEMORY_SCOPE_AGENT); }
__device__ __forceinline__ unsigned xb_xcc_id() { return (unsigned)__builtin_amdgcn_s_getreg((3 << 11) | 20) & 0xFu; }
#define XB_SPIN(cond, bar) do { unsigned _sp = 0; while (cond) { __builtin_amdgcn_s_sleep(1); \
    if ((++_sp & 255u) == 0u) { if (xb_ld(&(bar)[XB_TMO])) break; if (_sp > XB_SPIN_CAP) { atomicAdd(&(bar)[XB_TMO], 1u); break; } } } } while (0)
struct XcdBarrier { unsigned* bar; unsigned x; volatile LAS unsigned* st; };
__device__ __forceinline__ XcdBarrier xcd_barrier_post(unsigned* bar, volatile LAS unsigned* st) {
    XcdBarrier b; b.bar = bar; b.x = xb_xcc_id(); b.st = st;
    if (threadIdx.x == 0) (void)xb_add(&bar[XB_XCNT(b.x)], 1u);
    return b;
}
__device__ __forceinline__ void xcd_barrier_complete(unsigned* bar, unsigned x, unsigned& nloc, unsigned& nx) {
    const unsigned G = gridDim.x * gridDim.y * gridDim.z;
    unsigned sum, cnt, mine, sp = 0u;
    for (;;) {
        sum = 0u; cnt = 0u; mine = 0u;
#pragma unroll
        for (unsigned j = 0; j < 16; ++j) { const unsigned c = xb_ld(&bar[XB_XCNT(j)]); sum += c; cnt += (c > 0u) ? 1u : 0u; mine = (j == x) ? c : mine; }
        if (sum == G) break;
        __builtin_amdgcn_s_sleep(1);
        if ((++sp & 255u) == 0u) { if (xb_ld(&bar[XB_TMO])) break; if (sp > XB_SPIN_CAP) { atomicAdd(&bar[XB_TMO], 1u); break; } }
    }
    nloc = mine > 0u ? mine : 1u; nx = cnt > 0u ? cnt : 1u;
}
__device__ __forceinline__ void xcd_barrier(const XcdBarrier& b) {
    asm volatile("s_waitcnt vmcnt(0)" ::: "memory");
    __syncthreads();
    if (threadIdx.x == 0) {
        unsigned* bar = b.bar;
        __builtin_amdgcn_s_waitcnt(0);
        unsigned nloc = b.st[0], nx = b.st[1];
        if (nloc == 0u) { xcd_barrier_complete(bar, b.x, nloc, nx); b.st[0] = nloc; b.st[1] = nx; }
        const unsigned old = xb_add(&bar[XB_XSUB(b.x)], 1u);
        const unsigned gen = old / nloc;
        if (old + 1u == (gen + 1u) * nloc) {
            __builtin_amdgcn_fence(__ATOMIC_RELEASE, "agent");
            asm volatile("s_waitcnt vmcnt(0)" ::: "memory");
            const unsigned og = xb_add(&bar[XB_TOP], 1u);
            const unsigned tg = og / nx;
            if (og + 1u == (tg + 1u) * nx) xb_add(&bar[XB_TOPGEN], 1u);
            else XB_SPIN(xb_ld(&bar[XB_TOPGEN]) == tg, bar);
            __builtin_amdgcn_fence(__ATOMIC_ACQUIRE, "agent");
            xb_add(&bar[XB_XGEN(b.x)], 1u);
            asm volatile("s_waitcnt vmcnt(0)" ::: "memory");
        } else {
            XB_SPIN(xb_ld(&bar[XB_XGEN(b.x)]) == gen, bar);
            __builtin_amdgcn_fence(__ATOMIC_ACQUIRE, "agent");
            asm volatile("s_waitcnt vmcnt(0)" ::: "memory");
        }
    }
    __syncthreads();
}

#ifndef MK_SWAP1415
#define MK_SWAP1415 1
#endif
#ifndef MK_ST13_STATIC
#define MK_ST13_STATIC 1
#endif
constexpr int N_STAGES = 18;
__device__ __forceinline__ void wg_seam() {
    asm volatile("s_waitcnt vmcnt(0)" ::: "memory");
    __syncthreads();
    if (threadIdx.x < 64) { __builtin_amdgcn_fence(__ATOMIC_ACQUIRE, "agent"); asm volatile("s_waitcnt vmcnt(0)" ::: "memory"); }
    __syncthreads();
}
template <class Epi>
__device__ __forceinline__ void run_gemm(LAS unsigned char* lds, const bf16_t* A, int lda, const bf16_t* Bt, int ldb, int K, int nM, int nN, int pmPerGroup, size_t gstrideB, const Epi& E) {
    pg8::Gemm g{A, Bt, lda, ldb, K, nM, nN, pmPerGroup, gstrideB};
    const int pm = blockIdx.x;
    if (pm < nM) { pg8::PanelOrder S{pm, nN}; pg8::gemm_phase<Epi, pg8::PanelOrder>(lds, g, S, E); }
}
#ifndef MK_PHMASK
#define MK_PHMASK 0x3ffff
#endif
#define PH_ON(k) (((MK_PHMASK) >> (k)) & 1)
constexpr int NM = M_TOK / 256;

__device__ __forceinline__ void stage_hnorm(PArg P, int nwv) {
    const int lane = threadIdx.x & 63, wave = __builtin_amdgcn_readfirstlane(threadIdx.x >> 6);
    if (wave >= nwv) return;
    const int rpw = 256 / nwv;
    const float* x = P.in(I_X); bf16_t* xb = (bf16_t*)P.out(); float* r0 = (float*)(P.ws() + WS_R0);
    for (int pm = blockIdx.x; pm < NM; pm += gridDim.x)
        for (int i = 0; i < rpw; i += 4) {
            const int m0 = pm * 256 + wave * rpw + i;
            f32x4 v[4][4];
#pragma unroll
            for (int r = 0; r < 4; ++r) { const f32x4* xr = (const f32x4*)(x + (size_t)(m0 + r) * DM) + 2 * lane;
#pragma unroll
                for (int j = 0; j < 2; ++j) { v[r][2 * j] = xr[128 * j]; v[r][2 * j + 1] = xr[128 * j + 1]; } }
#pragma unroll
            for (int r = 0; r < 4; ++r) { float s = 0.f;
#pragma unroll
                for (int j = 0; j < 2; ++j) { const f32x4 a = v[r][2 * j], b = v[r][2 * j + 1];
                    s += (a.x * a.x + a.y * a.y) + (a.z * a.z + a.w * a.w) + (b.x * b.x + b.y * b.y) + (b.z * b.z + b.w * b.w);
                    u32x4 w; w.x = pk_bf16(a.x, a.y); w.y = pk_bf16(a.z, a.w); w.z = pk_bf16(b.x, b.y); w.w = pk_bf16(b.z, b.w); ((u32x4*)(xb + (size_t)(m0 + r) * DM))[lane + 64 * j] = w; }
                const float rr = rsqrtf(wave_sum(s) * (1.0f / DM) + RMS_EPS); if (lane == 0) r0[m0 + r] = rr; }
        }
}
__device__ __forceinline__ void stage_scan(PArg P) {
    const int tid = threadIdx.x; if (tid >= 256) return;
    const float* E = (const float*)(P.ws() + WS_E); bf16_t* Ap = (bf16_t*)(P.ws() + WS_AP); const float* AL = (const float*)(P.ws() + WS_AL);
    for (int pm = blockIdx.x; pm < NG * NROW_G / 256; pm += gridDim.x) {
        const int p = tid & 63, g = pm >> 3, b = 4 * (pm & 7) + (tid >> 6);
        const float ar = AL[(g * 64 + p) * 2], ai = AL[(g * 64 + p) * 2 + 1];
        float xr = 0.f, xi = 0.f; const size_t row0 = (size_t)g * NROW_G + (size_t)b * NCH;
        for (int k0 = 0; k0 < NCH; k0 += 8) {
            float er[8], ei[8];
#pragma unroll
            for (int k = 0; k < 8; ++k) { er[k] = E[(row0 + k0 + k) * 128 + p]; ei[k] = E[(row0 + k0 + k) * 128 + 64 + p]; }
#pragma unroll
            for (int k = 0; k < 8; ++k) {
                bf16_t* d = Ap + (row0 + k0 + k) * APK + p;
                d[0] = (bf16_t)(pk_bf16(xr, 0.f) & 0xffffu); d[64] = (bf16_t)(pk_bf16(xi, 0.f) & 0xffffu);
                const float nr = ar * xr - ai * xi + er[k], ni = ar * xi + ai * xr + ei[k]; xr = nr; xi = ni; }
        }
    }
}
#ifndef MK_EWR
#define MK_EWR 4
#endif
constexpr int EWR = MK_EWR;
template <int MODE>
__device__ __forceinline__ void stage_ew(PArg P, const bf16_t* XB, const bf16_t* Y, const float* g1, bf16_t* OB) {
    const int tid = threadIdx.x, lane = tid & 63, wave = tid >> 6;
    const float* rsq = (const float*)(P.ws() + WS_RSQ); float* r2o = (float*)(P.ws() + WS_R2); float* outf = P.out();
    f32x4 gv[2][2];
#pragma unroll
    for (int j = 0; j < 2; ++j) { gv[j][0] = *(const f32x4*)(g1 + (lane + 64 * j) * 8); gv[j][1] = *(const f32x4*)(g1 + (lane + 64 * j) * 8 + 4); }
    for (int pm = blockIdx.x; pm < NM; pm += gridDim.x) {
        for (int i = 0; i < 32; i += EWR) {
            const int m0 = pm * 256 + wave * 32 + i;
            u32x4 xw[EWR][2], yw[EWR][2]; float rs[EWR];
#pragma unroll
            for (int r = 0; r < EWR; ++r) { rs[r] = (lane < 16) ? rsq[(size_t)(m0 + r) * 16 + lane] : 0.f;
#pragma unroll
                for (int j = 0; j < 2; ++j) { const size_t e = (size_t)(m0 + r) * DM + (size_t)(lane + 64 * j) * 8; xw[r][j] = *(const u32x4*)(XB + e); yw[r][j] = *(const u32x4*)(Y + e); } }
#pragma unroll
            for (int r = 0; r < EWR; ++r) {
                const float rn = rsqrtf(wave_sum(rs[r]) * (1.0f / DM) + RMS_EPS);
                float s = 0.f;
#pragma unroll
                for (int j = 0; j < 2; ++j) {
                    const size_t e = (size_t)(m0 + r) * DM + (size_t)(lane + 64 * j) * 8;
                    float xv[8], yv[8], v[8]; unpack8(xw[r][j], xv); unpack8(yw[r][j], yv);
#pragma unroll
                    for (int k = 0; k < 4; ++k) { v[k] = xv[k] + yv[k] * rn * gv[j][0][k]; v[4 + k] = xv[4 + k] + yv[4 + k] * rn * gv[j][1][k]; }
                    if (MODE == 2) { *(f32x4*)(outf + e) = (f32x4){v[0], v[1], v[2], v[3]}; *(f32x4*)(outf + e + 4) = (f32x4){v[4], v[5], v[6], v[7]}; }
                    else { u32x4 w; w.x = pk_bf16(v[0], v[1]); w.y = pk_bf16(v[2], v[3]); w.z = pk_bf16(v[4], v[5]); w.w = pk_bf16(v[6], v[7]); *(u32x4*)(OB + e) = w; }
                    if (MODE == 0) {
#pragma unroll
                        for (int k = 0; k < 8; ++k) s += v[k] * v[k]; }
                }
                if (MODE == 0) { const float r2 = rsqrtf(wave_sum(s) * (1.0f / DM) + RMS_EPS); if (lane == 0) r2o[m0 + r] = r2; }
            }
        }
    }
}

__device__ __forceinline__ void stage_pconv(PArg P) {
    const int tid = threadIdx.x;
    for (int pm = blockIdx.x; pm < NM; pm += gridDim.x) {
        const f32x4* ps = (const f32x4*)(P.in(I_P) + (size_t)pm * 256 * PLE); u32x2* pd = (u32x2*)((bf16_t*)(P.ws() + WS_PB) + (size_t)pm * 256 * PLE);
#pragma unroll 4
        for (int i2 = tid; i2 < 256 * PLE / 4; i2 += NTHR) { const f32x4 v = ps[i2]; u32x2 w; w.x = pk_bf16(v.x, v.y); w.y = pk_bf16(v.z, v.w); pd[i2] = w; }
    }
}
__device__ __forceinline__ void grid_sync_probe() { cg::this_grid().sync(); }
__device__ __forceinline__ void run_stage(PArg P, LAS unsigned char* lds, int st) {
    unsigned char* ws = P.ws();
#define WSB(off) ((bf16_t*)(ws + (off)))
    switch (st) {
#if defined(MK_P0MODE)
    case 0: if constexpr (PH_ON(0)) { int nrep_ = MK_P0N; asm volatile("" : "+s"(nrep_)); for (int r_ = 0; r_ < nrep_; ++r_) { if (MK_P0MODE == 1) stage_hnorm(P, 8); else phase_prep(P, lds, MK_P0MODE - 1, 0); __syncthreads(); } }
            if constexpr (PH_ON(0)) { if (blockIdx.x & 1) { stage_hnorm(P, 8); __syncthreads(); phase_prep(P, lds, 3, 0); } else { phase_prep(P, lds, 3, 0); stage_hnorm(P, 8); } } break;
#elif MK_HNW == 8
    case 0: if constexpr (PH_ON(0)) { if (blockIdx.x & 1) { stage_hnorm(P, 8); __syncthreads(); phase_prep(P, lds, 3, 0); } else { phase_prep(P, lds, 3, 0); stage_hnorm(P, 8); } } break;
#else
    case 0: if constexpr (PH_ON(0)) { phase_prep(P, lds, 1, 0); stage_hnorm(P, MK_HNW); phase_prep(P, lds, 2, MK_HNW); } break;
#endif
    case 1: break;
    case 2: if constexpr (PH_ON(2)) { EpiIn E{WSB(WS_AP), WSB(WS_Q), WSB(WS_K), WSB(WS_V), WSB(WS_GA), WSB(WS_GB), (float*)(ws + WS_KMEAN), (const float*)(ws + WS_R0)};
              run_gemm(lds, (const bf16_t*)P.out(), DM, WSB(WS_WIN), DM, DM, NM, INC / 256, NM, 0, E); } break;
    case 3: if constexpr (PH_ON(3)) { EpiSsm1 E{(float*)(ws + WS_E)};
              run_gemm(lds, WSB(WS_AP) + 128, APK, WSB(WS_WS1), 512, 512, NG * NROW_G / 256, 1, NROW_G / 256, (size_t)256 * 512, E); } break;
    case 4: if constexpr (PH_ON(4)) stage_scan(P); break;
    case 5: if constexpr (PH_ON(5)) { EpiSsm2 E{WSB(WS_AP), P.in(I_DSK), WSB(WS_Y)};
              run_gemm(lds, WSB(WS_AP), APK, WSB(WS_WS2), APK, APK, NG * NROW_G / 256, 2, NROW_G / 256, (size_t)512 * APK, E); } break;
    case 6: if constexpr (PH_ON(6)) {
#if defined(MK_APROBE)
              att::attn_phase<MK_APROBE>(P, lds); __syncthreads();
#endif
#if MK_ATT2
#if defined(MK_APROBE2)
              { int nrep = MK_APREP; asm volatile("" : "+s"(nrep)); for (int i = 0; i < nrep; ++i) { att2::attn_phase<MK_THRL, MK_APROBE2>(P, lds); __syncthreads(); } }
#endif
              att2::attn_phase<MK_THRL, 0>(P, lds); } break;
#else
#if defined(MK_APREP)
              { int nrep = MK_APREP; asm volatile("" : "+s"(nrep)); for (int i = 0; i < nrep; ++i) { att::attn_phase<0>(P, lds); __syncthreads(); } }
#endif
              att::attn_phase<0>(P, lds); } break;
#endif
    case 7: if constexpr (PH_ON(7)) { EpiGen<EM_GLU, false> E{WSB(WS_GLU), SSM_W, WSB(WS_Y), nullptr, P.in(I_BGLU), nullptr};
              run_gemm(lds, WSB(WS_Y), SSM_W, WSB(WS_WGLU), SSM_W, SSM_W, NM, SSM_W / 256, NM, 0, E); } break;
    case 8: if constexpr (PH_ON(8)) { EpiGen<EM_GATE, false> E{WSB(WS_T1), DM, WSB(WS_GA), nullptr, nullptr, nullptr};
              run_gemm(lds, WSB(WS_GLU), SSM_W, WSB(WS_WA), SSM_W, SSM_W, NM, DM / 256, NM, 0, E); } break;
    case 9: if constexpr (PH_ON(9)) { EpiGen<EM_GATEADD, false> E{WSB(WS_MIXIN), DM, WSB(WS_GB), WSB(WS_T1), nullptr, nullptr};
              run_gemm(lds, WSB(WS_ATT), ATT_W, WSB(WS_WB), ATT_W, ATT_W, NM, DM / 256, NM, 0, E); } break;
    case 10: if constexpr (PH_ON(10)) { EpiGen<EM_PLAIN, true> E{WSB(WS_MIXED), DM, nullptr, nullptr, nullptr, (float*)(ws + WS_RSQ)};
              run_gemm(lds, WSB(WS_MIXIN), DM, WSB(WS_WOUT), DM, DM, NM, DM / 256, NM, 0, E); } break;
    case 11: if constexpr (PH_ON(11)) stage_ew<0>(P, (const bf16_t*)P.out(), WSB(WS_MIXED), P.in(I_GPOSTMIX), WSB(WS_H)); break;
    case 12: if constexpr (PH_ON(12)) {
#if defined(MK_PROBE) && (MK_PROBE == 2)
               { EpiGen<EM_PLAIN, false> EN{WSB(WS_HID), 256, nullptr, nullptr, nullptr, nullptr}; run_gemm(lds, WSB(WS_H), DM, WSB(WS_W1), DM, DM, NM, DFF / 256, NM, 0, EN); }
#elif defined(MK_PROBE)
               { EpiProbe<MK_PROBE> EN{nullptr}; run_gemm(lds, WSB(WS_H), DM, WSB(WS_W1), DM, DM, NM, DFF / 256, NM, 0, EN); }
#endif
               EpiGen<EM_RELU2, false> E{WSB(WS_HID), HID_LD, nullptr, nullptr, (const float*)(ws + WS_R2), nullptr};
               run_gemm(lds, WSB(WS_H), DM, WSB(WS_W1), DM, DM, NM, DFF / 256, NM, 0, E); } break;
    case 13: if constexpr (PH_ON(13)) {
#if defined(MK_PROBE13) && (MK_PROBE13 == 1)
               { EpiProbe<0> EN{nullptr}; run_gemm(lds, WSB(WS_HID), HID_LD, WSB(WS_W2), DFF, DFF, NM, DM / 256, NM, 0, EN); }
#elif defined(MK_PROBE13) && (MK_PROBE13 == 2)
               { EpiProbe<0> EN{nullptr}; pg8::Gemm g{WSB(WS_HID), WSB(WS_W2), HID_LD, DFF, DFF, NM, DM / 256, NM, 0}; pg8::StaticOrder S; S.init(NM, DM / 256, (int)gridDim.x, (int)blockIdx.x); grid_sync_probe(); pg8::gemm_phase<EpiProbe<0>, pg8::StaticOrder>(lds, g, S, EN); }
#endif
               EpiGen<EM_PLAIN, true> E{WSB(WS_F), DM, nullptr, nullptr, nullptr, (float*)(ws + WS_RSQ)};
#if MK_ST13_STATIC
               { pg8::Gemm g{WSB(WS_HID), WSB(WS_W2), HID_LD, DFF, DFF, NM, DM / 256, NM, 0}; pg8::StaticOrder S; S.init(NM, DM / 256, (int)gridDim.x, (int)blockIdx.x);
                 pg8::gemm_phase<EpiGen<EM_PLAIN, true>, pg8::StaticOrder>(lds, g, S, E); } } break;
#else
               run_gemm(lds, WSB(WS_HID), HID_LD, WSB(WS_W2), DFF, DFF, NM, DM / 256, NM, 0, E); } break;
#endif
    case 14: if constexpr (PH_ON(14)) stage_ew<1>(P, WSB(WS_H), WSB(WS_F), P.in(I_GPOSTMLP), WSB(WS_X2B)); break;
    case 15: if constexpr (PH_ON(15)) { stage_pconv(P); wg_seam(); EpiGen<EM_PLAIN, false> E{WSB(WS_PW), DM, nullptr, nullptr, nullptr, nullptr};
               run_gemm(lds, WSB(WS_PB), PLE, WSB(WS_WPLE), PLE, PLE, NM, DM / 256, NM, 0, E); } break;
    case 16: if constexpr (PH_ON(16)) { EpiGen<EM_MULSIG, true> E{WSB(WS_EE), DM, WSB(WS_PW), nullptr, nullptr, (float*)(ws + WS_RSQ)};
               run_gemm(lds, WSB(WS_X2B), DM, WSB(WS_WPG), DM, DM, NM, DM / 256, NM, 0, E); } break;
    case 17: if constexpr (PH_ON(17)) stage_ew<2>(P, WSB(WS_X2B), WSB(WS_EE), P.in(I_GPLE), nullptr); break;
    default: break;
    }
#undef WSB
}

__global__ void __launch_bounds__(NTHR, 2) mk_fwd(Params Pval) {
    extern __shared__ __attribute__((aligned(16))) unsigned char lds_raw[];
    LAS unsigned char* lds = (LAS unsigned char*)lds_raw;
    {
        const __attribute__((address_space(4))) unsigned* ka = (const __attribute__((address_space(4))) unsigned*)__builtin_amdgcn_kernarg_segment_ptr();
        if (threadIdx.x < 54) ((LAS unsigned*)(lds + LDS_PARAM_OFF))[threadIdx.x] = ka[threadIdx.x];
        else if (threadIdx.x < 64) ((LAS unsigned*)(lds + LDS_PARAM_OFF))[threadIdx.x] = 0u;
        __syncthreads();
    }
    const PArg P{(const LAS unsigned*)(lds + LDS_PARAM_OFF)};
#ifndef MK_XCDBAR
#define MK_XCDBAR 1
#endif
    XcdBarrier xbar = xcd_barrier_post((unsigned*)(P.ws() + WS_BAR), (volatile LAS unsigned*)(lds + LDS_PARAM_OFF + 224));
    cg::grid_group grid = cg::this_grid();
#ifndef MK_REPMASK
#define MK_REPMASK 0
#endif
#ifndef MK_REPN
#define MK_REPN 1
#endif
#define MK_SYNC(k, GRIDSYNC) { if (GRIDSYNC) { if (MK_XCDBAR && Pval.ph_hi <= N_STAGES) xcd_barrier(xbar); else grid.sync(); } else wg_seam(); }
#define MK_STAGE(k, GRIDSYNC) if (Pval.ph_lo <= (k) && (k) < Pval.ph_hi) { \
        if constexpr (((MK_REPMASK) >> (k)) & 1) { int nrep_ = MK_REPN; asm volatile("" : "+s"(nrep_)); for (int r_ = 0; r_ < nrep_; ++r_) { run_stage(P, lds, (k)); MK_SYNC(k, GRIDSYNC) } }     \
        run_stage(P, lds, (k)); if ((k) + 1 < Pval.ph_hi) MK_SYNC(k, GRIDSYNC) }
    MK_STAGE(0, true) MK_STAGE(1, false) MK_STAGE(2, true) MK_STAGE(3, false) MK_STAGE(4, false) MK_STAGE(5, false) MK_STAGE(6, true)
    MK_STAGE(7, false) MK_STAGE(8, false) MK_STAGE(9, false) MK_STAGE(10, false) MK_STAGE(11, true) MK_STAGE(12, MK_ST13_STATIC != 0) MK_STAGE(13, MK_ST13_STATIC != 0)
    if (Pval.ph_lo <= 14 && 16 <= Pval.ph_hi && MK_SWAP1415 && ((blockIdx.x >> 3) & 1)) {
        run_stage(P, lds, 15); wg_seam(); run_stage(P, lds, 14); if (16 < Pval.ph_hi) wg_seam();
    } else { MK_STAGE(14, false) MK_STAGE(15, false) }
    MK_STAGE(16, false) MK_STAGE(17, false)
#undef MK_STAGE
#undef MK_SYNC
}


extern "C" void kernel_launch(void* const* d_in, const int* in_sizes, int n_in, void* d_out, int out_size, void* d_ws, size_t ws_size, hipStream_t stream) {
    static int grid = 0;
    if (grid == 0) {
        if (n_in != 25 || out_size != M_TOK * DM || ws_size < WS_END) { fprintf(stderr, "kernel_launch: unexpected shapes (n_in %d out %d ws %zu)\n", n_in, out_size, ws_size); grid = -1; return; }
        int dev = 0, cus = 0, per_cu = 0;
        hipGetDevice(&dev); hipDeviceGetAttribute(&cus, hipDeviceAttributeMultiprocessorCount, dev);
        hipFuncSetAttribute((const void*)mk_fwd, hipFuncAttributeMaxDynamicSharedMemorySize, LDS_BYTES);
        hipOccupancyMaxActiveBlocksPerMultiprocessor(&per_cu, (const void*)mk_fwd, NTHR, LDS_BYTES);
        if (per_cu < 1) { fprintf(stderr, "kernel_launch: occupancy query says %d blocks/CU\n", per_cu); per_cu = 1; }
        grid = NM_PANELS;
        if (cus != NM_PANELS) fprintf(stderr, "kernel_launch: device reports %d CUs; this kernel is laid out for %d\n", cus, NM_PANELS);
        (void)hipGetLastError();
    }
    if (grid < 0) return;
    Params p{};
    for (int i = 0; i < 25; ++i) p.in[i] = (const float*)d_in[i];
    p.out = (float*)d_out; p.ws = (unsigned char*)d_ws;
    (void)hipMemsetAsync((char*)d_ws + WS_BAR, 0, 16384, stream);
#if MK_DEBUG
    dbg_run(p, grid, stream);
#elif MK_LAUNCHES == 1
    p.ph_lo = 0; p.ph_hi = N_STAGES;
    void* args[] = {&p};
    hipError_t e = hipLaunchCooperativeKernel((const void*)mk_fwd, dim3(grid), dim3(NTHR), args, LDS_BYTES, stream);
    if (e != hipSuccess) fprintf(stderr, "cooperative launch failed: %s (grid %d)\n", hipGetErrorString(e), grid);
#else
    for (int ph = 0; ph < N_STAGES; ++ph) { p.ph_lo = ph; p.ph_hi = ph + 1; hipLaunchKernelGGL(mk_fwd, dim3(grid), dim3(NTHR), LDS_BYTES, stream, p); }
#endif
}
```

```cpp
#include <hip/hip_runtime.h>
#include <hip/hip_cooperative_groups.h>
#include <cstdio>
#include <cstdint>
namespace cg = cooperative_groups;

#ifndef MK_DEBUG
#define MK_DEBUG 0
#endif
#ifndef MK_NTGATE
#define MK_NTGATE 1
#endif
#ifndef MK_NT
#define MK_NT 1
#endif
#ifndef MK_LAUNCHES
#define MK_LAUNCHES 1
#endif

#define LAS __attribute__((address_space(3)))
typedef unsigned short bf16_t;
typedef short bf16x8 __attribute__((ext_vector_type(8)));
typedef short s16x4 __attribute__((ext_vector_type(4)));
typedef float f32x4 __attribute__((ext_vector_type(4)));
typedef float f32x16 __attribute__((ext_vector_type(16)));
typedef unsigned u32x4 __attribute__((ext_vector_type(4)));
typedef unsigned u32x2 __attribute__((ext_vector_type(2)));
typedef float f32x2_t __attribute__((ext_vector_type(2)));
typedef __bf16 bf16x2_t __attribute__((ext_vector_type(2)));

constexpr int BATCH = 32, SEQ = 2048, DM = 1024, M_TOK = BATCH * SEQ;
constexpr int SSM_W = 512, NG = 32, GC = 16, NSTATE = 64;
constexpr int NHEAD = 8, HD = 64, ATT_W = 512, MBLK = 256, NBLK = 8;
constexpr int DFF = 4096, PLE = 256, INC = 4096;
constexpr float RMS_EPS = 1e-6f;
constexpr int CL = 32;
constexpr int NCH = SEQ / CL;
constexpr int NROW_G = BATCH * NCH;
constexpr int APK = 128 + CL * GC;
constexpr int NM_PANELS = M_TOK / 256;
constexpr float QSCALE = 0.125f * 1.4426950408889634f;

#ifndef MK_ST12_STATIC
#define MK_ST12_STATIC 1
#endif
#ifndef MK_ST2_STATIC
#define MK_ST2_STATIC 1
#endif
#ifndef MK_HNW
#define MK_HNW 8
#endif
constexpr size_t MiB = 1u << 20;
constexpr size_t WS_WIN = 0, WS_W1 = 8 * MiB, WS_W2 = 16 * MiB, WS_WOUT = 24 * MiB, WS_WPG = 26 * MiB, WS_WA = 28 * MiB, WS_WB = 29 * MiB;
constexpr size_t WS_WGLU = 30 * MiB, WS_WPLE = 30 * MiB + 512 * 1024, WS_WS1 = 31 * MiB, WS_WS2 = 39 * MiB;
constexpr size_t WS_AL = 59 * MiB, WS_R0 = 59 * MiB + 65536, WS_R2 = 59 * MiB + 65536 + 262144, WS_RSQ = 60 * MiB, WS_PB = 64 * MiB;
constexpr size_t WS_SC = 96 * MiB, WS_SA = 736 * MiB, WS_SB = 864 * MiB;
constexpr size_t WS_H = WS_SC, WS_T1 = WS_SC;
constexpr size_t WS_PW = 224 * MiB;
constexpr size_t WS_GA = WS_SA, WS_MIXIN = WS_SA, WS_F = WS_SA, WS_EE = WS_SA;
constexpr size_t WS_GB = WS_SB, WS_MIXED = WS_SB, WS_X2B = WS_SB;
constexpr size_t WS_AP = 224 * MiB, WS_E = 304 * MiB, WS_Q = 336 * MiB, WS_K = 400 * MiB, WS_V = 464 * MiB, WS_Y = 528 * MiB, WS_ATT = 592 * MiB;
constexpr size_t WS_GLU = WS_Q;
constexpr int HID_LD = DFF;
constexpr size_t WS_HID = 224 * MiB;
constexpr size_t WS_KMEAN = 992 * MiB;
constexpr size_t WS_BAR = 993 * MiB;
constexpr size_t WS_END = 994 * MiB;
static_assert(WS_V - WS_K == WS_K - WS_Q, "Q|K|V equally spaced");

__device__ __forceinline__ unsigned pk_bf16(float lo, float hi) { f32x2_t v = {lo, hi}; bf16x2_t b = __builtin_convertvector(v, bf16x2_t); return __builtin_bit_cast(unsigned, b); }
__device__ __forceinline__ float bf_lo(unsigned w) { return __uint_as_float(w << 16); }
__device__ __forceinline__ float bf_hi(unsigned w) { return __uint_as_float(w & 0xffff0000u); }
__device__ __forceinline__ float bf_round(float x) { return bf_lo(pk_bf16(x, 0.f) & 0xffffu); }
__device__ __forceinline__ float fsigmoid(float x) { return __builtin_amdgcn_rcpf(1.0f + __builtin_amdgcn_exp2f(-1.4426950408889634f * x)); }
__device__ __forceinline__ float gelu_tanh(float y) { const float z = 0.7978845608028654f * (y + 0.044715f * y * y * y); return y * __builtin_amdgcn_rcpf(1.0f + __builtin_amdgcn_exp2f(-2.885390081777927f * z)); }
__device__ __forceinline__ float wave_sum(float v) {
#pragma unroll
    for (int o = 1; o < 64; o <<= 1) v += __shfl_xor(v, o);
    return v;
}
__device__ __forceinline__ void unpack8(const u32x4 w, float* f) { f[0] = bf_lo(w.x); f[1] = bf_hi(w.x); f[2] = bf_lo(w.y); f[3] = bf_hi(w.y); f[4] = bf_lo(w.z); f[5] = bf_hi(w.z); f[6] = bf_lo(w.w); f[7] = bf_hi(w.w); }

namespace pg8 {
constexpr int BM = 256, BK = 64, HALF = 128, HTB = HALF * BK * 2, STAGE_BYTES = 8 * HTB, NXCD = 8, WGM = 8;
__device__ __forceinline__ int lds_byte(int r, int c) { const int st = (r >> 4) * 2 + (c >> 5), rr = r & 15, cc = c & 31, ob = rr * 64 + cc * 2; return st * 1024 + (ob ^ (((ob >> 9) & 1) << 5)); }
__device__ __forceinline__ void stage_rc(int b, int& R, int& C) { const int st = b / 1024, sb = b % 1024, swz = sb ^ (((sb >> 9) & 1) << 5); R = (st >> 1) * 16 + swz / 64; C = (st & 1) * 32 + (swz % 64) / 2; }
__device__ __forceinline__ int perm32(int rho) { const int n = rho >> 4, i = rho & 15; return 8 * (i >> 2) + 4 * n + (i & 3); }

struct Unit { int pm, pn; };
struct Gemm { const bf16_t* A; const bf16_t* Bt; int lda, ldb, K, nM, nN, pmPerGroup; size_t gstrideB; };

struct StaticOrder {
    int nM, nN, nwg, G, c;
    __device__ void init(int nM_, int nN_, int G_, int c_) { nM = nM_; nN = nN_; nwg = nM * nN; G = G_; c = c_; }
    __device__ bool next(int i, Unit& u) const {
        const long L = (long)i * G + c; if (L >= nwg) return false;
        int wgid = (int)L; { const int q = nwg / NXCD, r = nwg % NXCD, xcd = wgid % NXCD, off = wgid / NXCD; wgid = (xcd < r ? xcd * (q + 1) : r * (q + 1) + (xcd - r) * q) + off; }
        const int nig = WGM * nN, gid = wgid / nig, fm = gid * WGM, gsz = (nM - fm) < WGM ? (nM - fm) : WGM;
        u.pm = fm + ((wgid % nig) % gsz); u.pn = (wgid % nig) / gsz; return true;
    }
};

struct PanelOrder {
    int pm, nN;
    __device__ bool next(int i, Unit& u) const { if (i >= nN) return false; int pmo = pm; asm volatile("" : "+s"(pmo)); u.pm = pmo; u.pn = i; return true; }
};
template <class Epi, class Sched>
__device__ __forceinline__ void gemm_phase(LAS unsigned char* lds, const Gemm g, const Sched& S, const Epi& E) {
    const int tid = threadIdx.x, wid = __builtin_amdgcn_readfirstlane(tid >> 6), lane = tid & 63, wr = wid >> 2, wc = wid & 3, fr = lane & 15, fq = lane >> 4;
    int K = g.K; asm volatile("" : "+s"(K));
    const int nt = K / BK;
    unsigned voffA[2], voffB[2];
#pragma unroll
    for (int i = 0; i < 2; ++i) { int R, C; stage_rc(tid * 16 + i * 8192, R, C); const int Rb = Epi::PERM ? ((R & ~31) + perm32(R & 31)) : R;
        voffA[i] = (unsigned)(R * g.lda + C) * 2u; voffB[i] = (unsigned)(Rb * g.ldb + C) * 2u; }
    const size_t kstep = (size_t)(BK * 2);
    const size_t hstepA = (size_t)HALF * g.lda * 2, tstepA = 2 * hstepA;
    const size_t hstepB = (size_t)HALF * g.ldb * 2, tstepB = 2 * hstepB;
    const unsigned ldsw = (unsigned)wid * 1024u;
    const int aoff = lds_byte(wr * 64 + fr, fq * 8), boff = lds_byte(wc * 32 + fr, fq * 8);
#define PG8_SA(b, h) (((b) * 2 + (h)) * HTB)
#define PG8_SB(b, h) ((4 + (b) * 2 + (h)) * HTB)
#define PG8_STAGE(bufoff, gbase, voff) do { _Pragma("unroll") for (int _i = 0; _i < 2; ++_i) \
        __builtin_amdgcn_global_load_lds((const unsigned*)((const char*)(gbase) + (voff)[_i]), (LAS unsigned*)(lds + (bufoff) + ldsw + _i * 8192), 16, 0, 0); } while (0)
#define PG8_LDA(dst, b, h) do { _Pragma("unroll") for (int m = 0; m < 4; ++m) _Pragma("unroll") for (int k = 0; k < 2; ++k) dst[m][k] = *(const LAS bf16x8*)(lds + PG8_SA(b, h) + aoff + m * 2048 + k * 1024); } while (0)
#define PG8_LDB(dst, b, h) do { _Pragma("unroll") for (int n = 0; n < 2; ++n) _Pragma("unroll") for (int k = 0; k < 2; ++k) dst[n][k] = *(const LAS bf16x8*)(lds + PG8_SB(b, h) + boff + n * 2048 + k * 1024); } while (0)
#define PG8_MMA(ai, bj, At, Bt) do { __builtin_amdgcn_s_setprio(1); _Pragma("unroll") for (int m = 0; m < 4; ++m) _Pragma("unroll") for (int n = 0; n < 2; ++n) _Pragma("unroll") for (int k = 0; k < 2; ++k) \
        acc[ai][bj][m][n] = __builtin_amdgcn_mfma_f32_16x16x32_bf16(Bt[n][k], At[m][k], acc[ai][bj][m][n], 0, 0, 0); __builtin_amdgcn_s_setprio(0); } while (0)
#define PG8_WAIT_V(n) asm volatile("s_waitcnt vmcnt(" #n ")" ::: "memory")
#define PG8_WAIT_L(n) asm volatile("s_waitcnt lgkmcnt(" #n ")" ::: "memory")
#define PG8_BAR __builtin_amdgcn_s_barrier()
#define PG8_SCHED __builtin_amdgcn_sched_barrier(0)
#define PG8_ABASE(u) ((const char*)g.A + (size_t)(u).pm * tstepA)
#define PG8_BBASE(u) ((const char*)g.Bt + (size_t)((u).pm / g.pmPerGroup) * g.gstrideB * 2 + (size_t)(u).pn * tstepB)
    Unit cur, nxt; int ui = 0;
    if (!S.next(0, cur)) return;
    f32x4 acc[2][2][4][2];
#pragma unroll
    for (int a = 0; a < 2; ++a)
#pragma unroll
        for (int b = 0; b < 2; ++b)
#pragma unroll
            for (int m = 0; m < 4; ++m)
#pragma unroll
                for (int n = 0; n < 2; ++n) acc[a][b][m][n] = (f32x4){0.f, 0.f, 0.f, 0.f};
    bf16x8 At[4][2], B0[2][2], B1[2][2];
    const char* cA = PG8_ABASE(cur); const char* cB = PG8_BBASE(cur);
    PG8_STAGE(PG8_SB(0, 0), cB, voffB); PG8_STAGE(PG8_SB(0, 1), cB + hstepB, voffB); PG8_STAGE(PG8_SA(0, 0), cA, voffA); PG8_STAGE(PG8_SA(0, 1), cA + hstepA, voffA);
    if (wr == 1) PG8_BAR;
    PG8_WAIT_V(2); PG8_BAR;
    PG8_STAGE(PG8_SB(1, 0), cB + kstep, voffB); PG8_STAGE(PG8_SA(1, 0), cA + kstep, voffA); PG8_STAGE(PG8_SB(1, 1), cB + hstepB + kstep, voffB);
    PG8_WAIT_V(6); PG8_BAR;
    for (;;) {
        const bool has_next = S.next(ui + 1, nxt);
        const char* nA = has_next ? PG8_ABASE(nxt) : cA; const char* nB = has_next ? PG8_BBASE(nxt) : cB;
        for (int t = 0; t < nt; t += 2) {
            const bool last = (t == nt - 2);
            const char* a1 = cA + (size_t)(t + 1) * kstep;
            const char* a2 = last ? nA : cA + (size_t)(t + 2) * kstep; const char* b2 = last ? nB : cB + (size_t)(t + 2) * kstep;
            const char* a3 = a2 + kstep; const char* b3 = b2 + kstep;
            PG8_LDB(B0, 0, 0); PG8_LDB(B1, 0, 1); PG8_SCHED; PG8_LDA(At, 0, 0); PG8_STAGE(PG8_SA(1, 1), a1 + hstepA, voffA);
            PG8_WAIT_V(8); PG8_WAIT_L(0); PG8_BAR; PG8_MMA(0, 0, At, B0); PG8_MMA(0, 1, At, B1); PG8_BAR; PG8_SCHED;
            PG8_LDA(At, 0, 1); PG8_STAGE(PG8_SB(0, 0), b2, voffB); PG8_STAGE(PG8_SB(0, 1), b2 + hstepB, voffB); PG8_STAGE(PG8_SA(0, 0), a2, voffA);
            PG8_WAIT_V(8); PG8_WAIT_L(0); PG8_BAR; PG8_MMA(1, 0, At, B0); PG8_MMA(1, 1, At, B1); PG8_BAR; PG8_SCHED;
            PG8_LDB(B0, 1, 0); PG8_LDB(B1, 1, 1); PG8_SCHED; PG8_LDA(At, 1, 0); PG8_STAGE(PG8_SA(0, 1), a2 + hstepA, voffA);
            PG8_WAIT_V(8); PG8_WAIT_L(0); PG8_BAR; PG8_MMA(0, 0, At, B0); PG8_MMA(0, 1, At, B1); PG8_BAR; PG8_SCHED;
            PG8_LDA(At, 1, 1); PG8_STAGE(PG8_SB(1, 0), b3, voffB); PG8_STAGE(PG8_SB(1, 1), b3 + hstepB, voffB); PG8_STAGE(PG8_SA(1, 0), a3, voffA);
            PG8_WAIT_V(8); PG8_WAIT_L(0); PG8_BAR; PG8_MMA(1, 0, At, B0); PG8_MMA(1, 1, At, B1); PG8_BAR; PG8_SCHED;
        }
        if (wr == 0) PG8_BAR;
        E(acc, cur, wr, wc, fr, fq);
        if (!has_next) break;
#pragma unroll
        for (int a = 0; a < 2; ++a)
#pragma unroll
            for (int b = 0; b < 2; ++b)
#pragma unroll
                for (int m = 0; m < 4; ++m)
#pragma unroll
                    for (int n = 0; n < 2; ++n) acc[a][b][m][n] = (f32x4){0.f, 0.f, 0.f, 0.f};
        cur = nxt; cA = nA; cB = nB; ++ui;
        if (wr == 1) PG8_BAR;
    }
    PG8_WAIT_V(0);
    PG8_BAR;
#undef PG8_SA
#undef PG8_SB
#undef PG8_STAGE
#undef PG8_LDA
#undef PG8_LDB
#undef PG8_MMA
#undef PG8_WAIT_V
#undef PG8_WAIT_L
#undef PG8_BAR
#undef PG8_SCHED
#undef PG8_ABASE
#undef PG8_BBASE
}
}

typedef const f32x4 (&AccRef)[2][2][4][2];
#ifndef MK_NTQKV
#define MK_NTQKV 0
#endif
#if MK_NTQKV
#define EPI_ST(p, v) __builtin_nontemporal_store((v), (p))
#else
#define EPI_ST(p, v) (*(p) = (v))
#endif
#define EPI_ROWS(ai, m) for (int ai = 0; ai < 2; ++ai) _Pragma("unroll") for (int m = 0; m < 4; ++m)
__device__ __forceinline__ u32x4 pack8(const f32x4 a, const f32x4 b) { u32x4 w; w.x = pk_bf16(a[0], a[1]); w.y = pk_bf16(a[2], a[3]); w.z = pk_bf16(b[0], b[1]); w.w = pk_bf16(b[2], b[3]); return w; }

struct EpiIn {
    static constexpr bool PERM = true;
    bf16_t* Ap; bf16_t* Q; bf16_t* Kb; bf16_t* Vb; bf16_t* GA; bf16_t* GB; float* kmean; const float* r0;
    __device__ __forceinline__ void operator()(AccRef acc_, const pg8::Unit& u, int wr, int wc, int fr, int fq) const {
        const int pn = u.pn, row0 = u.pm * 256 + wr * 64 + fr, colw = wc * 32 + 8 * fq;
        f32x4 acc[2][2][4][2];
#pragma unroll
        EPI_ROWS(ai, m) { const float rs = r0[row0 + ai * 128 + m * 16];
#pragma unroll
            for (int bj = 0; bj < 2; ++bj) { acc[ai][bj][m][0] = acc_[ai][bj][m][0] * rs; acc[ai][bj][m][1] = acc_[ai][bj][m][1] * rs; } }
        if (pn < 2) {
            const int b = u.pm >> 3, s0 = (u.pm & 7) * 256 + wr * 64 + fr;
#pragma unroll
            EPI_ROWS(ai, m) { const int s = s0 + ai * 128 + m * 16, n = b * NCH + (s >> 5), i = s & 31;
#pragma unroll
                for (int bj = 0; bj < 2; ++bj) { const int col = pn * 256 + bj * 128 + colw, gg = col >> 4, c0 = col & 15;
                    *(u32x4*)(Ap + ((size_t)(gg * NROW_G + n)) * APK + 128 + i * 16 + c0) = pack8(acc[ai][bj][m][0], acc[ai][bj][m][1]); } }
        } else if (pn < 8) {
            bf16_t* dst = Q + (size_t)((pn - 2) >> 1) * ((WS_K - WS_Q) / 2); const int cbase = (pn & 1) * 256 + colw; const float sc = (pn < 4) ? QSCALE : 1.0f;
#pragma unroll
            EPI_ROWS(ai, m) { const size_t row = (size_t)(row0 + ai * 128 + m * 16);
#pragma unroll
                for (int bj = 0; bj < 2; ++bj) EPI_ST((u32x4*)(dst + row * 512 + cbase + bj * 128), pack8(acc[ai][bj][m][0] * sc, acc[ai][bj][m][1] * sc)); }
            if (pn == 4 || pn == 5) {
                f32x4 c00 = (f32x4){0.f, 0.f, 0.f, 0.f}, c01 = c00, c10 = c00, c11 = c00;
#pragma unroll
                EPI_ROWS(ai, m) { c00 += acc[ai][0][m][0]; c01 += acc[ai][0][m][1]; c10 += acc[ai][1][m][0]; c11 += acc[ai][1][m][1]; }
#pragma unroll
                for (int j = 0; j < 4; ++j) {
                    float a = c00[j], b = c01[j], c = c10[j], d = c11[j];
#pragma unroll
                    for (int o = 1; o < 16; o <<= 1) { a += __shfl_xor(a, o); b += __shfl_xor(b, o); c += __shfl_xor(c, o); d += __shfl_xor(d, o); }
                    c00[j] = a; c01[j] = b; c10[j] = c; c11[j] = d;
                }
                if (fr == 0) {
                    float* km = kmean + ((size_t)wr * NM_PANELS + u.pm) * 512 + cbase;
                    *(f32x4*)(km) = c00 * (1.0f / 256.0f); *(f32x4*)(km + 4) = c01 * (1.0f / 256.0f); *(f32x4*)(km + 128) = c10 * (1.0f / 256.0f); *(f32x4*)(km + 132) = c11 * (1.0f / 256.0f);
                }
            }
        } else {
            bf16_t* dst = GA + (size_t)((pn - 8) >> 2) * ((WS_GB - WS_GA) / 2); const int cbase = ((pn - 8) & 3) * 256 + colw;
#pragma unroll
            EPI_ROWS(ai, m) { const size_t row = (size_t)(row0 + ai * 128 + m * 16);
#pragma unroll
                for (int bj = 0; bj < 2; ++bj) { f32x4 a = acc[ai][bj][m][0], c = acc[ai][bj][m][1];
#pragma unroll
                    for (int j = 0; j < 4; ++j) { a[j] = fsigmoid(a[j]); c[j] = fsigmoid(c[j]); }
#if MK_NTGATE
                    __builtin_nontemporal_store(pack8(a, c), (u32x4*)(dst + row * 1024 + cbase + bj * 128)); } }
#else
                    EPI_ST((u32x4*)(dst + row * 1024 + cbase + bj * 128), pack8(a, c)); } }
#endif
        }
    }
};
struct EpiSsm1 {
    static constexpr bool PERM = false;
    float* E;
    __device__ __forceinline__ void operator()(AccRef acc, const pg8::Unit& u, int wr, int wc, int fr, int fq) const {
        const int row0 = u.pm * 256 + wr * 64 + fr, col0 = wc * 32 + 4 * fq;
#pragma unroll
        EPI_ROWS(ai, m) { float* rp = E + (size_t)(row0 + ai * 128 + m * 16) * 128 + col0;
#pragma unroll
            for (int n = 0; n < 2; ++n) *(f32x4*)(rp + n * 16) = acc[ai][0][m][n]; }
    }
};
struct EpiSsm2 {
    static constexpr bool PERM = true;
    const bf16_t* Ap; const float* dsk; bf16_t* Y;
    __device__ __forceinline__ void operator()(AccRef acc, const pg8::Unit& u, int wr, int wc, int fr, int fq) const {
        const int gg = u.pm >> 3, nl0 = (u.pm & 7) * 256 + wr * 64 + fr;
#pragma unroll
        for (int bj = 0; bj < 2; ++bj) {
            const int col = u.pn * 256 + bj * 128 + wc * 32 + 8 * fq, i = col >> 4, c0 = col & 15;
            const f32x4 d0 = *(const f32x4*)(dsk + gg * 16 + c0), d1 = *(const f32x4*)(dsk + gg * 16 + c0 + 4);
#pragma unroll
            EPI_ROWS(ai, m) { const int n = nl0 + ai * 128 + m * 16, b = n >> 6, ch = n & 63;
                const u32x4 uw = *(const u32x4*)(Ap + ((size_t)(gg * NROW_G + n)) * APK + 128 + col);
                float uf[8]; unpack8(uw, uf);
                f32x4 a = acc[ai][bj][m][0], c = acc[ai][bj][m][1];
#pragma unroll
                for (int j = 0; j < 4; ++j) { a[j] = gelu_tanh(a[j] + d0[j] * uf[j]); c[j] = gelu_tanh(c[j] + d1[j] * uf[4 + j]); }
                *(u32x4*)(Y + ((size_t)(b * SEQ + ch * CL + i)) * SSM_W + gg * 16 + c0) = pack8(a, c);
                if (m & 1) asm volatile("" ::: "memory"); }
        }
    }
};
enum { EM_PLAIN = 0, EM_GLU = 1, EM_GATE = 2, EM_GATEADD = 3, EM_RELU2 = 4, EM_MULSIG = 5 };
template <int MODE, bool ROWSQ>
struct EpiGen {
    static constexpr bool PERM = true;
    bf16_t* O; int ldc; const bf16_t* X1; const bf16_t* X2; const float* bias; float* rsq;
    __device__ __forceinline__ void operator()(AccRef acc, const pg8::Unit& u, int wr, int wc, int fr, int fq) const {
        const int row0 = u.pm * 256 + wr * 64 + fr, col0 = u.pn * 256 + wc * 32 + 8 * fq;
        float bv[2][8];
        if (MODE == EM_GLU) {
#pragma unroll
            for (int bj = 0; bj < 2; ++bj) { const f32x4 b0 = *(const f32x4*)(bias + col0 + bj * 128), b1 = *(const f32x4*)(bias + col0 + bj * 128 + 4);
#pragma unroll
                for (int j = 0; j < 4; ++j) { bv[bj][j] = b0[j]; bv[bj][4 + j] = b1[j]; } }
        }
#pragma unroll
        EPI_ROWS(ai, m) { const size_t off = (size_t)(row0 + ai * 128 + m * 16) * ldc + col0; float sq = 0.f;
#pragma unroll
            for (int bj = 0; bj < 2; ++bj) {
                float v[8];
#pragma unroll
                for (int j = 0; j < 4; ++j) { v[j] = acc[ai][bj][m][0][j]; v[4 + j] = acc[ai][bj][m][1][j]; }
                if (MODE == EM_GLU) { float x[8]; unpack8(*(const u32x4*)(X1 + off + bj * 128), x);
#pragma unroll
                    for (int j = 0; j < 8; ++j) v[j] = x[j] * fsigmoid(v[j] + bv[bj][j]); }
                if (MODE == EM_GATE) { float x[8]; unpack8(*(const u32x4*)(X1 + off + bj * 128), x);
#pragma unroll
                    for (int j = 0; j < 8; ++j) v[j] = x[j] * v[j]; }
                if (MODE == EM_GATEADD) { float x[8], t[8]; unpack8(*(const u32x4*)(X1 + off + bj * 128), x); unpack8(*(const u32x4*)(X2 + off + bj * 128), t);
#pragma unroll
                    for (int j = 0; j < 8; ++j) v[j] = t[j] + x[j] * v[j]; }
                if (MODE == EM_RELU2) { const float rs = bias[row0 + ai * 128 + m * 16];
#pragma unroll
                    for (int j = 0; j < 8; ++j) { const float r = fmaxf(v[j], 0.f) * rs; v[j] = r * r; } }
                if (MODE == EM_MULSIG) { float x[8]; unpack8(*(const u32x4*)(X1 + off + bj * 128), x);
#pragma unroll
                    for (int j = 0; j < 8; ++j) v[j] = x[j] * fsigmoid(v[j]); }
                if (ROWSQ) {
#pragma unroll
                    for (int j = 0; j < 8; ++j) sq += v[j] * v[j]; }
                u32x4 w; w.x = pk_bf16(v[0], v[1]); w.y = pk_bf16(v[2], v[3]); w.z = pk_bf16(v[4], v[5]); w.w = pk_bf16(v[6], v[7]);
#if defined(MK_NT)
                if (MODE == EM_RELU2 || MK_NT >= 2) __builtin_nontemporal_store(w, (u32x4*)(O + off + bj * 128)); else
#endif
                *(u32x4*)(O + off + bj * 128) = w;
            }
            if (ROWSQ) { sq += __shfl_xor(sq, 16); sq += __shfl_xor(sq, 32);
                if (fq == 0) rsq[(size_t)(row0 + ai * 128 + m * 16) * 16 + u.pn * 4 + wc] = sq; }
            if (m & 1) asm volatile("" ::: "memory");
        }
    }
};

template <int VARIANT>
struct EpiProbe {
    static constexpr bool PERM = true;
    bf16_t* scratch;
    __device__ __forceinline__ void operator()(AccRef acc, const pg8::Unit& u, int wr, int wc, int fr, int fq) const {
#pragma unroll
        EPI_ROWS(ai, m)
#pragma unroll
            for (int bj = 0; bj < 2; ++bj) {
                if (VARIANT == 0) asm volatile("" :: "v"(acc[ai][bj][m][0]), "v"(acc[ai][bj][m][1]));
                if (VARIANT == 1) { f32x4 a = acc[ai][bj][m][0], c = acc[ai][bj][m][1];
#pragma unroll
                    for (int j = 0; j < 4; ++j) { const float r0 = fmaxf(a[j], 0.f) * 1.01f, r1 = fmaxf(c[j], 0.f) * 1.01f; a[j] = r0 * r0; c[j] = r1 * r1; }
                    const u32x4 w = pack8(a, c); asm volatile("" :: "v"(w)); }
                if (VARIANT == 2) { const u32x4 w = pack8(acc[ai][bj][m][0], acc[ai][bj][m][1]);
                    bf16_t* sp = scratch + (size_t)blockIdx.x * 65536 + (wr * 64 + fr) * 256 + wc * 32 + 8 * fq;
                    *(u32x4*)(sp + (ai * 128 + m * 16) * 256 + bj * 128) = w; if (bj) asm volatile("" ::: "memory"); }
            }
    }
};
struct Params { const float* in[25]; float* out; unsigned char* ws; int ph_lo, ph_hi; };
constexpr int LDS_PARAM_OFF = 131072;
struct PArg {
    const LAS unsigned* b;
    __device__ __forceinline__ unsigned long long q(int i) const { const unsigned lo = __builtin_amdgcn_readfirstlane(b[2 * i]), hi = __builtin_amdgcn_readfirstlane(b[2 * i + 1]); return ((unsigned long long)hi << 32) | lo; }
    __device__ __forceinline__ const float* in(int i) const { return (const float*)(const __attribute__((address_space(1))) float*)q(i); }
    __device__ __forceinline__ float* out() const { return (float*)(__attribute__((address_space(1))) float*)q(25); }
    __device__ __forceinline__ unsigned char* ws() const { return (unsigned char*)(__attribute__((address_space(1))) unsigned char*)q(26); }
};
constexpr int NWAVES = 8, NTHR = 512;
constexpr int LDS_BYTES = 131072 + 4096;
enum { I_X = 0, I_P, I_GPRE, I_WIN, I_LRE, I_LIM, I_LDT, I_BRE, I_BIM, I_CRE, I_CIM, I_DSK, I_WGLU, I_BGLU, I_WA, I_WB, I_WOUT, I_GPOSTMIX, I_GPREMLP, I_W1, I_W2, I_GPOSTMLP, I_WPLE, I_WPG, I_GPLE };

__device__ __forceinline__ void transpose_item(const float* W, const float* gain, int K, int N, bf16_t* WT, LAS float* scr, int item, int lane) {
    const int nblk = N / 32, kb = item / nblk, nb = item % nblk, k0 = 64 * kb, n0 = 32 * nb;
#pragma unroll
    for (int i = 0; i < 32; ++i) { const int kk = 2 * i + (lane >> 5); scr[kk * 33 + (lane & 31)] = W[(size_t)(k0 + kk) * N + n0 + (lane & 31)] * (gain ? gain[k0 + kk] : 1.0f); }
    asm volatile("s_waitcnt lgkmcnt(0)" ::: "memory");
    const int c = lane & 7;
#pragma unroll
    for (int j = 0; j < 4; ++j) { const int n = (lane >> 3) + 8 * j; const LAS float* s = scr + (8 * c) * 33 + n;
        u32x4 o; o.x = pk_bf16(s[0 * 33], s[1 * 33]); o.y = pk_bf16(s[2 * 33], s[3 * 33]); o.z = pk_bf16(s[4 * 33], s[5 * 33]); o.w = pk_bf16(s[6 * 33], s[7 * 33]);
        *(u32x4*)(WT + (size_t)(n0 + n) * K + k0 + 8 * c) = o; }
    asm volatile("s_waitcnt lgkmcnt(0)" ::: "memory");
}

__device__ __forceinline__ void ssm_weights_group(PArg P, LAS unsigned char* lds, int g, int c0, int nc) {
    const int tid = threadIdx.x;
    LAS double* zr = (LAS double*)lds;
    LAS double* zi = zr + 64;
    LAS double* cfr = zi + 64;
    LAS double* cfi = cfr + 64;
    LAS float* apw = (LAS float*)(cfi + 64);
    LAS float* bb = apw + 33 * 64 * 2;
    LAS float* cc = bb + 64 * 16 * 2;
    LAS float* kt = cc + 128;
    const float* lre = P.in(I_LRE); const float* lim = P.in(I_LIM); const float* ldt = P.in(I_LDT);
    if (tid < 64) {
        const int p = tid; const double lr = lre[g * 64 + p], li = lim[g * 64 + p], dt = exp((double)ldt[g]);
        const double a = lr * dt, b = li * dt, er = exp(a), ar = er * cos(b), ai = er * sin(b);
        const double nr = ar - 1.0, ni = ai, den = lr * lr + li * li;
        zr[p] = a; zi[p] = b; cfr[p] = (nr * lr + ni * li) / den; cfi[p] = (ni * lr - nr * li) / den;
    }
    __syncthreads();
    for (int e = tid; e < 33 * 64; e += NTHR) { const int tau = e >> 6, p = e & 63; const double er = exp(zr[p] * tau), an = zi[p] * tau; apw[2 * e] = (float)(er * cos(an)); apw[2 * e + 1] = (float)(er * sin(an)); }
    for (int e = tid; e < 64 * 16; e += NTHR) { const int p = e >> 4; const double br = P.in(I_BRE)[(size_t)(g * 64) * 16 + e], bi = P.in(I_BIM)[(size_t)(g * 64) * 16 + e];
        bb[2 * e] = (float)(cfr[p] * br - cfi[p] * bi); bb[2 * e + 1] = (float)(cfr[p] * bi + cfi[p] * br); }
    for (int c = c0; c < c0 + nc; ++c) {
    if (tid < 64) { cc[2 * tid] = P.in(I_CRE)[(size_t)(g * 16 + c) * 64 + tid]; cc[2 * tid + 1] = P.in(I_CIM)[(size_t)(g * 16 + c) * 64 + tid]; }
    __syncthreads();
    {
        const int tau = tid >> 4, cp = tid & 15; float s = 0.f;
        for (int p = 0; p < 64; ++p) { const float cr = cc[2 * p], ci = cc[2 * p + 1], ar = apw[2 * (tau * 64 + p)], ai = apw[2 * (tau * 64 + p) + 1];
            const float pr = cr * ar - ci * ai, pi = cr * ai + ci * ar; s += pr * bb[2 * (p * 16 + cp)] - pi * bb[2 * (p * 16 + cp) + 1]; }
        kt[tid] = s;
    }
    __syncthreads();
    bf16_t* W2 = (bf16_t*)(P.ws() + WS_WS2) + (size_t)g * 512 * APK;
    for (int e = tid; e < 32 * (APK / 2); e += NTHR) {
        const int i = e / (APK / 2), k = 2 * (e % (APK / 2)); float v[2];
#pragma unroll
        for (int d = 0; d < 2; ++d) { const int kk = k + d;
            if (kk < 128) { const int ri = kk >> 6, p = kk & 63; const float cr = cc[2 * p], ci = cc[2 * p + 1], ar = apw[2 * ((i + 1) * 64 + p)], ai = apw[2 * ((i + 1) * 64 + p) + 1];
                v[d] = ri == 0 ? (cr * ar - ci * ai) : -(cr * ai + ci * ar); }
            else { const int ip = (kk - 128) >> 4, cp = kk & 15, tau = i - ip; v[d] = tau >= 0 ? kt[tau * 16 + cp] : 0.f; } }
        *(unsigned*)(W2 + (size_t)(i * 16 + c) * APK + k) = pk_bf16(v[0], v[1]);
    }
    bf16_t* W1 = (bf16_t*)(P.ws() + WS_WS1) + (size_t)g * 256 * 512;
    for (int e = tid; e < 16 * 256; e += NTHR) {
        const int r = c * 16 + (e >> 8), k = 2 * (e & 255); float v[2] = {0.f, 0.f};
        if (r < 128) { const int ri = r >> 6, p = r & 63;
#pragma unroll
            for (int d = 0; d < 2; ++d) { const int kk = k + d, ip = kk >> 4, cp = kk & 15; const float ar = apw[2 * ((31 - ip) * 64 + p)], ai = apw[2 * ((31 - ip) * 64 + p) + 1], br = bb[2 * (p * 16 + cp)], bi = bb[2 * (p * 16 + cp) + 1];
                v[d] = ri == 0 ? (ar * br - ai * bi) : (ar * bi + ai * br); } }
        *(unsigned*)(W1 + (size_t)r * 512 + k) = pk_bf16(v[0], v[1]);
    }
    if (c == 0 && tid < 64) { float* al = (float*)(P.ws() + WS_AL) + (size_t)(g * 64 + tid) * 2; al[0] = apw[2 * (32 * 64 + tid)]; al[1] = apw[2 * (32 * 64 + tid) + 1]; }
    __syncthreads();
    }
}

__device__ __forceinline__ void phase_prep(PArg P, LAS unsigned char* lds, int part, int w0) {
    const int tid = threadIdx.x, lane = tid & 63, wave = __builtin_amdgcn_readfirstlane(tid >> 6), G = gridDim.x;
    unsigned char* ws = P.ws();
    if (part & 1) {
        if (G * 2 == NG * GC) ssm_weights_group(P, lds, blockIdx.x >> 3, 2 * (blockIdx.x & 7), 2);
        else for (int job = blockIdx.x; job < NG * GC; job += G) ssm_weights_group(P, lds, job >> 4, job & 15, 1);
    }
    if (!(part & 2) || wave < w0) return;
    LAS float* scr = (LAS float*)(lds + wave * 16384);
    const int gw = blockIdx.x * (NWAVES - w0) + (wave - w0), NGW = G * (NWAVES - w0);
    struct TJ { int idx, K, N; size_t off; int gi; };
    const TJ tj[9] = {{I_WIN, 1024, 4096, WS_WIN, I_GPRE}, {I_W1, 1024, 4096, WS_W1, I_GPREMLP}, {I_W2, 4096, 1024, WS_W2, -1}, {I_WOUT, 1024, 1024, WS_WOUT, -1}, {I_WPG, 1024, 1024, WS_WPG, -1},
                      {I_WA, 512, 1024, WS_WA, -1}, {I_WB, 512, 1024, WS_WB, -1}, {I_WGLU, 512, 512, WS_WGLU, -1}, {I_WPLE, 256, 1024, WS_WPLE, -1}};
    int base = 0;
#pragma unroll
    for (int j = 0; j < 9; ++j) { const int items = (tj[j].K / 64) * (tj[j].N / 32);
        const float* gain = tj[j].gi >= 0 ? P.in(tj[j].gi) : nullptr;
        for (int it = (gw + NGW - base % NGW) % NGW; it < items; it += NGW) transpose_item(P.in(tj[j].idx), gain, tj[j].K, tj[j].N, (bf16_t*)(ws + tj[j].off), scr, it, lane);
        base += items; }
}

namespace att {
constexpr int L_K = 0, L_V = 16384, L_KM = 32768, L_WS = 36864, L_OST = 38912, L_END = L_OST + 8 * 4096;
#ifndef MK_THR
#define MK_THR 8.0f
#endif
constexpr float NEG = -1e30f, THR = MK_THR;
__device__ __forceinline__ int crow(int r, int hi) { return (r & 3) + 8 * (r >> 2) + 4 * hi; }
__device__ __forceinline__ s16x4 vtr(const LAS unsigned char* p) { typedef short v4i16_t __attribute__((ext_vector_type(4))); return __builtin_bit_cast(s16x4, __builtin_amdgcn_ds_read_tr16_b64_v4i16((LAS v4i16_t*)p)); }

template <int AV>
__device__ __forceinline__ void attn_phase(PArg P, LAS unsigned char* lds) {
    const int tid = threadIdx.x, lane = tid & 63, wid = __builtin_amdgcn_readfirstlane(tid >> 6), r32 = lane & 31, hi = lane >> 5;
    const bf16_t* Q = (const bf16_t*)(P.ws() + WS_Q); const bf16_t* Kb = (const bf16_t*)(P.ws() + WS_K); const bf16_t* Vb = (const bf16_t*)(P.ws() + WS_V);
    const float* kmean = (const float*)(P.ws() + WS_KMEAN); bf16_t* O = (bf16_t*)(P.ws() + WS_ATT);
    LAS float* wsf = (LAS float*)(lds + L_WS) + wid * 64;
    const int srow = tid >> 3, sch = tid & 7;
    const int kst = srow * 128 + ((sch ^ ((srow >> 1) & 7)) << 4), vst = srow * 128 + ((sch ^ (((srow >> 1) & 1) << 2)) << 4);
    const int kswz = (r32 >> 1) & 7;
    int kfo[4];
#pragma unroll
    for (int ks = 0; ks < 4; ++ks) kfo[ks] = r32 * 128 + (((2 * ks + hi) ^ kswz) << 4);
    const int q4 = (lane & 15) >> 2, p4 = lane & 3, blk = (lane >> 4) & 1, vswz = ((q4 >> 1) & 1) << 2, cl = 2 * blk + (p4 >> 1);
    const int vrow = (4 * hi + q4) * 128 + 8 * (p4 & 1);
    const int vo0 = vrow + ((vswz + cl) << 4), vo1 = vrow + (((4 ^ vswz) + cl) << 4);
    for (int bh = blockIdx.x; bh < BATCH * NHEAD; bh += gridDim.x) {
        const int b = bh >> 3, h = bh & 7;
        __syncthreads();
        if (tid < 256) {
            const int row = tid >> 3, ch = tid & 7; u32x4 w = (u32x4){0u, 0u, 0u, 0u};
            if (row < 16) { const float* km = kmean + (size_t)(b * NBLK + (row & 7)) * ATT_W + h * HD + ch * 8; float v[8];
#pragma unroll
                for (int j = 0; j < 8; ++j) { const float x = km[j] + km[(size_t)NM_PANELS * 512 + j], xh = bf_round(x); v[j] = (row < 8) ? xh : (x - xh); }
                w.x = pk_bf16(v[0], v[1]); w.y = pk_bf16(v[2], v[3]); w.z = pk_bf16(v[4], v[5]); w.w = pk_bf16(v[6], v[7]); }
            *(LAS u32x4*)(lds + L_KM + row * 128 + ((ch ^ ((row >> 1) & 7)) << 4)) = w;
        }
        __syncthreads();
        const bf16_t* Kh = Kb + (size_t)b * SEQ * ATT_W + h * HD; const bf16_t* Vh = Vb + (size_t)b * SEQ * ATT_W + h * HD;
        for (int jb = 0; jb < NBLK; ++jb) {
            const int q0 = jb * MBLK + wid * 32;
            const bf16_t* Qrow = Q + ((size_t)(b * SEQ + q0 + r32)) * ATT_W + h * HD;
            bf16x8 qr[4];
#pragma unroll
            for (int ks = 0; ks < 4; ++ks) qr[ks] = *(const bf16x8*)(Qrow + 16 * ks + 8 * hi);
            unsigned sel = 0;
            {
                f32x16 gz;
#pragma unroll
                for (int r = 0; r < 16; ++r) gz[r] = 0.f;
#pragma unroll
                for (int ks = 0; ks < 4; ++ks) { const bf16x8 kf = *(const LAS bf16x8*)(lds + L_KM + kfo[ks]); gz = __builtin_amdgcn_mfma_f32_32x32x16_bf16(kf, qr[ks], gz, 0, 0, 0); }
                float gate[8];
#pragma unroll
                for (int r = 0; r < 4; ++r) { const float mine = gz[r] + gz[r + 4], oth = __shfl_xor(mine, 32); gate[r] = hi ? oth : mine; gate[r + 4] = hi ? mine : oth; }
#pragma unroll
                for (int it = 0; it < 3; ++it) { int best = -1; float bv = 0.f;
#pragma unroll
                    for (int n = 0; n < 8; ++n) { const bool ok = (n < jb) && !((sel >> n) & 1u); if (ok && (best < 0 || gate[n] > bv)) { best = n; bv = gate[n]; } }
                    if (best >= 0) sel |= 1u << best; }
            }
            const int NT = 4 * (jb + 1);
            float mref, lsum, cbias; bool started;
            f32x16 o0, o1, biasv;
            bool robust = false;
            for (;;) {
            mref = 0.f; lsum = 0.f; cbias = 0.f; started = false;
#pragma unroll
            for (int r = 0; r < 16; ++r) { o0[r] = 0.f; o1[r] = 0.f; biasv[r] = 0.f; }
            u32x4 kA, vA, kB, vB;
#define ATT_LD(kr, vr, tt) do { kr = *(const u32x4*)(Kh + (size_t)((tt) * 64 + srow) * ATT_W + sch * 8); vr = *(const u32x4*)(Vh + (size_t)((tt) * 64 + srow) * ATT_W + sch * 8); } while (0)
#define ATT_ST(kr, vr, bufo) do { *(LAS u32x4*)(lds + L_K + (bufo) + kst) = kr; *(LAS u32x4*)(lds + L_V + (bufo) + vst) = vr; } while (0)
            ATT_LD(kA, vA, 0); ATT_LD(kB, vB, 1);
            ATT_ST(kA, vA, 0);
            __syncthreads();
#define ATT_TILE(t, buf) do { \
                const int nb = (t) >> 2, to = (t) & 3; const bool own = (nb == jb); \
                const bool lane_sel = own || ((sel >> nb) & 1u); \
                const bool active = own ? (to <= (wid >> 1)) : (__any(lane_sel) != 0); \
                if (active) { \
                    const float bias = lane_sel ? -mref : NEG; \
                    if (__any(bias != cbias)) { cbias = bias; _Pragma("unroll") for (int r = 0; r < 16; ++r) biasv[r] = bias; } \
                    f32x16 p0, p1; \
                    const LAS unsigned char* kb_ = lds + L_K + (buf); \
                    if (AV == 4) { p0 = biasv; p1 = biasv; asm volatile("" : "+v"(p0), "+v"(p1)); } else { \
                    { const bf16x8 k0 = *(const LAS bf16x8*)(kb_ + kfo[0]), k1 = *(const LAS bf16x8*)(kb_ + 4096 + kfo[0]); \
                      p0 = __builtin_amdgcn_mfma_f32_32x32x16_bf16(k0, qr[0], biasv, 0, 0, 0); p1 = __builtin_amdgcn_mfma_f32_32x32x16_bf16(k1, qr[0], biasv, 0, 0, 0); } \
                    _Pragma("unroll") for (int ks = 1; ks < 4; ++ks) { \
                        const bf16x8 k0 = *(const LAS bf16x8*)(kb_ + kfo[ks]), k1 = *(const LAS bf16x8*)(kb_ + 4096 + kfo[ks]); \
                        p0 = __builtin_amdgcn_mfma_f32_32x32x16_bf16(k0, qr[ks], p0, 0, 0, 0); p1 = __builtin_amdgcn_mfma_f32_32x32x16_bf16(k1, qr[ks], p1, 0, 0, 0); } } \
                      \
                    const LAS unsigned char* vb_ = lds + L_V + (buf); \
                    bf16x8 vfa[4], vfb[4]; \
                    if (AV != 2) { _Pragma("unroll") for (int kk = 0; kk < 4; ++kk) { \
                        const int ro = (32 * (kk >> 1) + 16 * (kk & 1)) * 128; \
                        const s16x4 a0 = vtr(vb_ + ro + vo0), a1 = vtr(vb_ + ro + 8 * 128 + vo0); \
                        const s16x4 c0 = vtr(vb_ + ro + vo1), c1 = vtr(vb_ + ro + 8 * 128 + vo1); \
                        vfa[kk] = __builtin_shufflevector(a0, a1, 0, 1, 2, 3, 4, 5, 6, 7); vfb[kk] = __builtin_shufflevector(c0, c1, 0, 1, 2, 3, 4, 5, 6, 7); } } \
                    if (own && to == (wid >> 1)) { const int ql = (wid & 1) * 32 + r32; \
                        _Pragma("unroll") for (int r = 0; r < 16; ++r) { const int kl = crow(r, hi); if (kl > ql) p0[r] = NEG; if (kl + 32 > ql) p1[r] = NEG; } } \
                    if (robust) { \
                    float mx = fmaxf(p0[0], p1[0]); \
                    _Pragma("unroll") for (int r = 1; r < 16; ++r) mx = fmaxf(fmaxf(mx, p0[r]), p1[r]); \
                    mx = fmaxf(mx, __shfl_xor(mx, 32)); \
                    const bool valid = mx > -1e29f; \
                    const bool need = valid && (!started || mx > THR); \
                    if (__any(need)) { \
                        const float dl = need ? mx : 0.f; \
                        const float f = (need && started) ? __builtin_amdgcn_exp2f(-dl) : 1.0f; \
                        mref += dl; lsum *= f; \
                        _Pragma("unroll") for (int r = 0; r < 16; ++r) { p0[r] -= dl; p1[r] -= dl; } \
                        if (hi == 0) wsf[r32] = f; \
                        asm volatile("s_waitcnt lgkmcnt(0)" ::: "memory"); \
                        _Pragma("unroll") for (int r = 0; r < 16; ++r) { const float fr_ = wsf[crow(r, hi)]; o0[r] *= fr_; o1[r] *= fr_; } \
                    } \
                    started = started || valid; } \
                    float ls = 0.f; \
                    if (AV != 1) { _Pragma("unroll") for (int r = 0; r < 16; ++r) { p0[r] = __builtin_amdgcn_exp2f(p0[r]); p1[r] = __builtin_amdgcn_exp2f(p1[r]); ls += p0[r] + p1[r]; } } \
                    lsum += ls; \
                    bf16x8 pa[4]; \
                    _Pragma("unroll") for (int s2 = 0; s2 < 2; ++s2) { u32x4 w0, w1; \
                        w0.x = pk_bf16(p0[8 * s2 + 0], p0[8 * s2 + 1]); w0.y = pk_bf16(p0[8 * s2 + 2], p0[8 * s2 + 3]); w0.z = pk_bf16(p0[8 * s2 + 4], p0[8 * s2 + 5]); w0.w = pk_bf16(p0[8 * s2 + 6], p0[8 * s2 + 7]); \
                        w1.x = pk_bf16(p1[8 * s2 + 0], p1[8 * s2 + 1]); w1.y = pk_bf16(p1[8 * s2 + 2], p1[8 * s2 + 3]); w1.z = pk_bf16(p1[8 * s2 + 4], p1[8 * s2 + 5]); w1.w = pk_bf16(p1[8 * s2 + 6], p1[8 * s2 + 7]); \
                        pa[s2] = __builtin_bit_cast(bf16x8, w0); pa[2 + s2] = __builtin_bit_cast(bf16x8, w1); } \
                    if (AV == 2) { asm volatile("" :: "v"(pa[0]), "v"(pa[1]), "v"(pa[2]), "v"(pa[3])); } else \
                    _Pragma("unroll") for (int kk = 0; kk < 4; ++kk) { \
                        o0 = __builtin_amdgcn_mfma_f32_32x32x16_bf16(pa[kk], vfa[kk], o0, 0, 0, 0); \
                        o1 = __builtin_amdgcn_mfma_f32_32x32x16_bf16(pa[kk], vfb[kk], o1, 0, 0, 0); } \
                } } while (0)
            for (int t = 0; t < NT; t += 2) {
                if (AV != 3) { if (t + 2 < NT) ATT_LD(kA, vA, t + 2); }
                ATT_TILE(t, 0);
                if (AV != 3) { ATT_ST(kB, vB, 8192);
                __syncthreads();
                if (t + 3 < NT) ATT_LD(kB, vB, t + 3); }
                ATT_TILE(t + 1, 8192);
                if (AV != 3) { if (t + 2 < NT) ATT_ST(kA, vA, 0);
                __syncthreads(); }
            }
            lsum += __shfl_xor(lsum, 32);
            if (robust || AV != 0) break;
            {
#if defined(MK_FORCE_ROBUST)
                const bool bad = true;
#else
                const bool bad = !(lsum > 1e-30f && lsum < 1e30f);
#endif
                LAS unsigned* fl = (LAS unsigned*)(lds + L_END);
                const unsigned wb = __any(bad) ? 1u : 0u;
                if (lane == 0) fl[wid] = wb;
                __syncthreads();
                unsigned anyb = 0;
#pragma unroll
                for (int w8 = 0; w8 < 8; ++w8) anyb |= fl[w8];
                __syncthreads();
                if (!anyb) break;
                robust = true;
            }
            }
#undef ATT_LD
#undef ATT_ST
#undef ATT_TILE
            if (hi == 0) wsf[32 + r32] = lsum;
            asm volatile("s_waitcnt lgkmcnt(0)" ::: "memory");
            LAS bf16_t* stg = (LAS bf16_t*)(lds + L_OST) + wid * 2048;
#pragma unroll
            for (int r = 0; r < 16; ++r) { const int orow = crow(r, hi); const float rl = __builtin_amdgcn_rcpf(wsf[32 + orow]);
                stg[orow * 64 + r32] = (bf16_t)(pk_bf16(o0[r] * rl, 0.f) & 0xffffu); stg[orow * 64 + 32 + r32] = (bf16_t)(pk_bf16(o1[r] * rl, 0.f) & 0xffffu); }
            asm volatile("s_waitcnt lgkmcnt(0)" ::: "memory");
            if (AV != 0) { asm volatile("" :: "v"(o0), "v"(o1), "v"(lsum)); continue; }
            bf16_t* Ow = O + ((size_t)(b * SEQ + q0)) * ATT_W + h * HD;
#pragma unroll
            for (int i = 0; i < 4; ++i) { const int row = i * 8 + (lane >> 3), ch = lane & 7; const u32x4 v = *(const LAS u32x4*)(stg + row * 64 + ch * 8); *(u32x4*)(Ow + (size_t)row * ATT_W + ch * 8) = v; }
        }
    }
}
}


#ifndef MK_ATT2
#define MK_ATT2 1
#endif
#ifndef MK_THRL
#define MK_THRL 8
#endif
namespace att2 {
constexpr int NSLOT = 3, SLOTB = 8192;
constexpr int L_K = 0, L_V = NSLOT * SLOTB, L_WS = 2 * NSLOT * SLOTB, L_OST = L_WS + 8 * 64 * 4, L_KM = L_OST + 8 * 4096, L_END = L_KM + 4096;
constexpr float NEGB = -1e30f;
__device__ __forceinline__ int crow(int r, int hi) { return (r & 3) + 8 * (r >> 2) + 4 * hi; }
#define SBAR() __builtin_amdgcn_sched_barrier(0)
#define WAIT_BAR(N) asm volatile("s_waitcnt vmcnt(" #N ") lgkmcnt(0)\n\ts_barrier" ::: "memory")
__device__ __forceinline__ void glds16(const void* gsrc, unsigned lds_dst) { unsigned keep;
    asm volatile("s_mov_b32 %0, m0\n\ts_mov_b32 m0, %2\n\ts_nop 0\n\tglobal_load_lds_dwordx4 %1, off\n\ts_mov_b32 m0, %0" : "=&s"(keep) : "v"(gsrc), "s"(lds_dst) : "memory"); }
__device__ __forceinline__ float max3f(float a, float b, float c) { float r; asm("v_max3_f32 %0, %1, %2, %3" : "=v"(r) : "v"(a), "v"(b), "v"(c)); return r; }
__device__ __forceinline__ float max2f(float a, float b) { float r; asm("v_max_f32_e32 %0, %1, %2" : "=v"(r) : "v"(a), "v"(b)); return r; }
__device__ __forceinline__ float fadd_s(float a, float b) { float r; asm("v_add_f32_e32 %0, %1, %2" : "=v"(r) : "v"(a), "v"(b)); return r; }
__device__ __forceinline__ float fsub_s(float a, float b) { float r; asm("v_sub_f32_e32 %0, %1, %2" : "=v"(r) : "v"(a), "v"(b)); return r; }
__device__ __forceinline__ unsigned cvtpk_s(float lo, float hi) { f32x2_t v = {lo, hi}; bf16x2_t b = __builtin_convertvector(v, bf16x2_t); return __builtin_bit_cast(unsigned, b); }
typedef const LAS unsigned char* lds_cptr;
typedef short v4i16_t __attribute__((ext_vector_type(4)));
__device__ __forceinline__ void cmask(f32x16& p0, f32x16& p1, int jb, int qrel, int hi) {
    const float NEG = -INFINITY; const int kb = 64 * jb + 4 * hi;
#pragma unroll
    for (int r = 0; r < 16; ++r) { const int kv = kb + (r & 3) + 8 * (r >> 2); if (kv > qrel) p0[r] = NEG; if (kv + 32 > qrel) p1[r] = NEG; }
}
__device__ __forceinline__ void qkt(f32x16& p0, f32x16& p1, lds_cptr kb, const bf16x8* qr, const f32x16& negm) {
#pragma unroll
    for (int d0 = 0; d0 < 4; ++d0) {
        const bf16x8 b0 = *(const LAS bf16x8*)(kb + d0 * 2048);
        const bf16x8 b1 = *(const LAS bf16x8*)(kb + d0 * 2048 + 512);
        if (d0 == 0) { p0 = __builtin_amdgcn_mfma_f32_32x32x16_bf16(b0, qr[0], negm, 0, 0, 0); p1 = __builtin_amdgcn_mfma_f32_32x32x16_bf16(b1, qr[0], negm, 0, 0, 0); }
        else { p0 = __builtin_amdgcn_mfma_f32_32x32x16_bf16(b0, qr[d0], p0, 0, 0, 0); p1 = __builtin_amdgcn_mfma_f32_32x32x16_bf16(b1, qr[d0], p1, 0, 0, 0); } }
}
__device__ __forceinline__ void kload8(bf16x8* kf, lds_cptr kp) {
    kf[0] = *(const LAS bf16x8*)(kp);        kf[1] = *(const LAS bf16x8*)(kp + 512);
    kf[2] = *(const LAS bf16x8*)(kp + 2048); kf[3] = *(const LAS bf16x8*)(kp + 2560);
    kf[4] = *(const LAS bf16x8*)(kp + 4096); kf[5] = *(const LAS bf16x8*)(kp + 4608);
    kf[6] = *(const LAS bf16x8*)(kp + 6144); kf[7] = *(const LAS bf16x8*)(kp + 6656);
}
__device__ __forceinline__ void kload2(bf16x8* kf, lds_cptr kp, int j) { kf[2 * j] = *(const LAS bf16x8*)(kp + j * 2048); kf[2 * j + 1] = *(const LAS bf16x8*)(kp + j * 2048 + 512); }
__device__ __forceinline__ s16x4 vtr(lds_cptr p) { return __builtin_bit_cast(s16x4, __builtin_amdgcn_ds_read_tr16_b64_v4i16((LAS v4i16_t*)p)); }
__device__ __forceinline__ float rowmax(const f32x16& p0, const f32x16& p1) {
    float a = max3f(p0[0], p0[1], p1[0]), b = max3f(p0[2], p0[3], p1[1]); a = max3f(a, p1[2], p1[3]);
#pragma unroll
    for (int r = 4; r < 16; r += 4) { a = max3f(a, p0[r], p0[r + 1]); b = max3f(b, p0[r + 2], p0[r + 3]); a = max3f(a, p1[r], p1[r + 1]); b = max3f(b, p1[r + 2], p1[r + 3]); }
    const float m = max2f(a, b);
    auto rr = __builtin_amdgcn_permlane32_swap(__float_as_uint(m), __float_as_uint(m), false, false);
    return max2f(__uint_as_float(rr[0]), __uint_as_float(rr[1]));
}
__device__ __forceinline__ void pv(f32x16* o, int vb, bf16x8 pa0, bf16x8 pa1, bf16x8 pa2, bf16x8 pa3) {
#pragma unroll
    for (int d0 = 0; d0 < 2; ++d0) { s16x4 lo[4], hi[4];
#pragma unroll
        for (int ks = 0; ks < 4; ++ks) {
            asm volatile("ds_read_b64_tr_b16 %0,%1 offset:%c2" : "=&v"(lo[ks]) : "v"(vb), "i"(d0 * 4096 + ks * 1024) : "memory");
            asm volatile("ds_read_b64_tr_b16 %0,%1 offset:%c2" : "=&v"(hi[ks]) : "v"(vb), "i"(d0 * 4096 + ks * 1024 + 512) : "memory"); }
        asm volatile("s_waitcnt lgkmcnt(0)" ::: "memory"); SBAR();
#define PK(k) (bf16x8){lo[k][0], lo[k][1], lo[k][2], lo[k][3], hi[k][0], hi[k][1], hi[k][2], hi[k][3]}
        o[d0] = __builtin_amdgcn_mfma_f32_32x32x16_bf16(pa0, PK(0), o[d0], 0, 0, 0);
        o[d0] = __builtin_amdgcn_mfma_f32_32x32x16_bf16(pa1, PK(1), o[d0], 0, 0, 0);
        o[d0] = __builtin_amdgcn_mfma_f32_32x32x16_bf16(pa2, PK(2), o[d0], 0, 0, 0);
        o[d0] = __builtin_amdgcn_mfma_f32_32x32x16_bf16(pa3, PK(3), o[d0], 0, 0, 0);
#undef PK
    }
}

template <int THRL, int PM>
__device__ __forceinline__ void attn_phase(PArg P, LAS unsigned char* lds) {
    const int tid = threadIdx.x; const int wid = __builtin_amdgcn_readfirstlane(tid >> 6);
    const bf16_t* Q = (const bf16_t*)(P.ws() + WS_Q); const bf16_t* Kb = (const bf16_t*)(P.ws() + WS_K); const bf16_t* Vb = (const bf16_t*)(P.ws() + WS_V);
    const float* kmean = (const float*)(P.ws() + WS_KMEAN); bf16_t* O = (bf16_t*)(P.ws() + WS_ATT);
    LAS float* wsf = (LAS float*)(lds + L_WS) + wid * 64;
    const unsigned lds0 = (unsigned)(uintptr_t)lds;
    const unsigned kdst = lds0 + L_K + wid * 1024, vdst = lds0 + L_V + wid * 1024;
    for (int bh = blockIdx.x; bh < BATCH * NHEAD; bh += gridDim.x) {
        const int b = bh >> 3, h = bh & 7;
        __syncthreads();
        if (tid < 256) {
            const int row = tid >> 3, ch = tid & 7; u32x4 w = (u32x4){0u, 0u, 0u, 0u};
            if (row < 16) { const float* km = kmean + (size_t)(b * NBLK + (row & 7)) * ATT_W + h * HD + ch * 8; float v[8];
#pragma unroll
                for (int j = 0; j < 8; ++j) { const float x = km[j] + km[(size_t)NM_PANELS * 512 + j], xh = bf_round(x); v[j] = (row < 8) ? xh : (x - xh); }
                w.x = pk_bf16(v[0], v[1]); w.y = pk_bf16(v[2], v[3]); w.z = pk_bf16(v[4], v[5]); w.w = pk_bf16(v[6], v[7]); }
            *(LAS u32x4*)(lds + L_KM + row * 128 + ((ch ^ ((row >> 1) & 7)) << 4)) = w;
        }
        __syncthreads();
        const int bk = (PM == 2) ? 0 : b, hk = (PM == 2) ? 0 : h;
        const bf16_t* Kh = Kb + (size_t)bk * SEQ * ATT_W + hk * HD; const bf16_t* Vh = Vb + (size_t)bk * SEQ * ATT_W + hk * HD;
#define DMA_K(t, slot) glds16(ksrc + (size_t)(t) * 64 * ATT_W, (unsigned)__builtin_amdgcn_readfirstlane(kdst + (slot)))
#define DMA_V(t, slot) glds16(vsrc + (size_t)(t) * 64 * ATT_W, (unsigned)__builtin_amdgcn_readfirstlane(vdst + (slot)))
#define NXT(x) (((x) == (NSLOT - 1) * SLOTB) ? 0 : (x) + SLOTB)
        int ring0 = 0;
        bf16x8 qr[4];
        {
            int tido = tid; asm volatile("" : "+v"(tido));
            const int lane = tido & 63, r32 = lane & 31, hi = lane >> 5;
            const bf16_t* ksrc = Kh + (size_t)lane * ATT_W + wid * 8;
            const bf16_t* vsrc = Vh + (size_t)(16 * (wid & 3) + (lane >> 2)) * ATT_W + (wid >> 2) * 32 + (lane & 3) * 8;
            const bf16_t* Qw = Q + ((size_t)(b * SEQ + wid * 32)) * ATT_W + h * HD;
            DMA_K(0, 0); DMA_V(0, 0); DMA_K(1, SLOTB);
#pragma unroll
            for (int d0 = 0; d0 < 4; ++d0) qr[d0] = *(const bf16x8*)(Qw + (size_t)r32 * ATT_W + d0 * 16 + hi * 8);
            DMA_K(2, 2 * SLOTB);
        }
        for (int jb = 0; jb < NBLK; ++jb) {
            int jbo = jb; asm volatile("" : "+s"(jbo));
            int tido = tid; asm volatile("" : "+v"(tido));
            const int lane = tido & 63, r32 = lane & 31, hi = lane >> 5;
            const int vb0 = (int)(lds0 + L_V) + ((lane >> 4) & 1) * 32 + (lane & 3) * 8 + (4 * hi + ((lane & 15) >> 2)) * 64;
            const lds_cptr kp0 = lds + L_K + hi * 1024 + r32 * 16;
            const lds_cptr vp0 = lds + L_V + ((lane >> 4) & 1) * 32 + (lane & 3) * 8 + (4 * hi + ((lane & 15) >> 2)) * 64;
            const int qrel = wid * 32 + r32;
            const bf16_t* ksrc = Kh + (size_t)lane * ATT_W + wid * 8;
            const bf16_t* vsrc = Vh + (size_t)(16 * (wid & 3) + (lane >> 2)) * ATT_W + (wid >> 2) * 32 + (lane & 3) * 8;
            const int q0 = jbo * MBLK;
            const bf16_t* Qw = Q + ((size_t)(b * SEQ + q0 + wid * 32)) * ATT_W + h * HD;
            const int NT = (PM == 1) ? 4 : 4 * (jbo + 1);
            unsigned sel = 0;
            {
                const int kswz = (r32 >> 1) & 7;
                f32x16 gz;
#pragma unroll
                for (int r = 0; r < 16; ++r) gz[r] = 0.f;
#pragma unroll
                for (int ks = 0; ks < 4; ++ks) { const bf16x8 kf_ = *(const LAS bf16x8*)(lds + L_KM + r32 * 128 + (((2 * ks + hi) ^ kswz) << 4)); gz = __builtin_amdgcn_mfma_f32_32x32x16_bf16(kf_, qr[ks], gz, 0, 0, 0); }
                float gate[8];
#pragma unroll
                for (int r = 0; r < 4; ++r) { const float mine = gz[r] + gz[r + 4], oth = __shfl_xor(mine, 32); gate[r] = hi ? oth : mine; gate[r + 4] = hi ? mine : oth; }
#pragma unroll
                for (int it = 0; it < 3; ++it) { int best = -1; float bv = 0.f;
#pragma unroll
                    for (int n = 0; n < 8; ++n) { const bool ok = (n < jbo) && !((sel >> n) & 1u); if (ok && (best < 0 || gate[n] > bv)) { best = n; bv = gate[n]; } }
                    if (best >= 0) sel |= 1u << best; }
                sel |= (PM == 1) ? 1u : (1u << jbo);
            }
            bf16x8 kf[8];
            float mhat = 0.f, l_reg = 0.f; f32x16 o[2]; f32x16 negm; bool started = false;
#pragma unroll
            for (int r = 0; r < 16; ++r) { o[0][r] = 0.f; o[1][r] = 0.f; }
            { const float nb_ = (sel & 1u) ? 0.f : NEGB;
#pragma unroll
              for (int r = 0; r < 16; ++r) negm[r] = nb_; }
            asm volatile("" : "+v"(negm));
#define CMASK(P0, P1, t) do { int jb_ = (t) - (NT - 4); if (jb_ >= 0) cmask(P0, P1, jb_, qrel, hi); } while (0)
#define SETNEGM(tn) do { const float nb_ = ((sel >> ((tn) >> 2)) & 1u) ? -mhat : NEGB; _Pragma("unroll") for (int r = 0; r < 16; ++r) negm[r] = nb_; asm volatile("" : "+v"(negm)); } while (0)
            bool resc = false;
#define START(P0, P1) do { const float rm = rowmax(P0, P1); resc = false; \
                { const bool valid_ = rm > -1e29f; const float dl = valid_ ? rm : 0.f; started = valid_; mhat = fadd_s(mhat, dl); \
                  _Pragma("unroll") for (int r = 0; r < 16; ++r) { P0[r] = fsub_s(P0[r], dl); P1[r] = fsub_s(P1[r], dl); } \
                  SETNEGM(1); } \
                _Pragma("unroll") for (int r = 0; r < 16; ++r) P0[r] = __builtin_amdgcn_exp2f(P0[r]); } while (0)
#define RESC() do { if (resc) { asm volatile("s_waitcnt lgkmcnt(0)" ::: "memory"); \
                _Pragma("unroll") for (int d_ = 0; d_ < 2; ++d_) _Pragma("unroll") for (int r = 0; r < 16; ++r) o[d_][r] *= wsf[crow(r, hi)]; } } while (0)
            f32x16 pA0, pA1, pB0, pB1;
            int sl_prev = ring0, sl_cur = ring0, sl_next = NXT(ring0);
#define ROT() do { sl_prev = sl_cur; sl_cur = sl_next; sl_next = NXT(sl_next); } while (0)
            WAIT_BAR(3);
            qkt(pA0, pA1, kp0 + sl_cur, qr, negm); asm volatile("s_nop 15\n\ts_nop 7" : "+v"(pA0), "+v"(pA1)); CMASK(pA0, pA1, 0);
            START(pA0, pA1);
#pragma unroll
            for (int r = 0; r < 16; ++r) pA1[r] = __builtin_amdgcn_exp2f(pA1[r]);
            WAIT_BAR(0);
            DMA_K(3, sl_cur); DMA_V(1, sl_next);
            ROT();
            kload8(kf, kp0 + sl_cur);
            WAIT_BAR(2);
            s16x4 vlo[8], vhi[8]; u32x4 pw0, pw1, pw2, pw3;
#define PKW(P, B) cvtpk_s(P[B], P[B + 1])
#define PAF(k) __builtin_bit_cast(bf16x8, pw##k)
#define VFR(i) (bf16x8){vlo[i][0], vlo[i][1], vlo[i][2], vlo[i][3], vhi[i][0], vhi[i][1], vhi[i][2], vhi[i][3]}
#define PIN(x) asm volatile("" : "+v"(x))
#define MX3(a, b, c) __builtin_fmaxf(__builtin_fmaxf((a), (b)), (c))
#define GAPA(MF, A0, A1, A2, A3, W0, W1, PW) do { MF; sacc += A0; sacc += A1; sacc += A2; sacc += A3; PIN(sacc); W0; W1; PIN(PW); SBAR(); } while (0)
#define EX(v) __builtin_amdgcn_exp2f(v)
#define GAPB(MF, X, B) do { MF; X[B] = EX(X[B]); X[B + 1] = EX(X[B + 1]); X[B + 2] = EX(X[B + 2]); X[B + 3] = EX(X[B + 3]); PIN(X); SBAR(); } while (0)
#define VRD(i) do { vlo[i] = vtr(vp_ + (((i) >> 2) * 4096 + ((i) & 3) * 1024)); vhi[i] = vtr(vp_ + (((i) >> 2) * 4096 + ((i) & 3) * 1024 + 512)); } while (0)
#define KRD(G, j) do { if (G) { kload2(kf, kp0 + sl_next, j); SBAR(); } } while (0)
#define STEP(C0, C1, P0, P1, t, GK, GV, GL) do { SBAR(); \
    const lds_cptr vp_ = vp0 + sl_prev; \
    VRD(0); SBAR(); float sacc = (P0[0] + P0[1]); \
    GAPA(C0 = __builtin_amdgcn_mfma_f32_32x32x16_bf16(kf[0], qr[0], negm, 0, 0, 0), P0[2], P0[3], P0[4], P0[5],     pw0[0] = PKW(P0, 0), pw0[1] = PKW(P0, 2), pw0); \
    VRD(4); SBAR(); GAPA(C1 = __builtin_amdgcn_mfma_f32_32x32x16_bf16(kf[1], qr[0], negm, 0, 0, 0), P0[6], P0[7], P0[8], P0[9],     pw0[2] = PKW(P0, 4), pw0[3] = PKW(P0, 6), pw0); \
    VRD(1); SBAR(); GAPA(C0 = __builtin_amdgcn_mfma_f32_32x32x16_bf16(kf[2], qr[1], C0, 0, 0, 0),   P0[10], P0[11], P0[12], P0[13], pw1[0] = PKW(P0, 8), pw1[1] = PKW(P0, 10), pw1); \
    VRD(5); SBAR(); GAPA(C1 = __builtin_amdgcn_mfma_f32_32x32x16_bf16(kf[3], qr[1], C1, 0, 0, 0),   P0[14], P0[15], P1[0], P1[1],   pw1[2] = PKW(P0, 12), pw1[3] = PKW(P0, 14), pw1); \
    VRD(2); SBAR(); GAPA(C0 = __builtin_amdgcn_mfma_f32_32x32x16_bf16(kf[4], qr[2], C0, 0, 0, 0),   P1[2], P1[3], P1[4], P1[5],     pw2[0] = PKW(P1, 0), pw2[1] = PKW(P1, 2), pw2); \
    VRD(6); SBAR(); GAPA(C1 = __builtin_amdgcn_mfma_f32_32x32x16_bf16(kf[5], qr[2], C1, 0, 0, 0),   P1[6], P1[7], P1[8], P1[9],     pw2[2] = PKW(P1, 4), pw2[3] = PKW(P1, 6), pw2); \
    VRD(3); SBAR(); GAPA(C0 = __builtin_amdgcn_mfma_f32_32x32x16_bf16(kf[6], qr[3], C0, 0, 0, 0),   P1[10], P1[11], P1[12], P1[13], pw3[0] = PKW(P1, 8), pw3[1] = PKW(P1, 10), pw3); \
    VRD(7); SBAR(); GAPA(C1 = __builtin_amdgcn_mfma_f32_32x32x16_bf16(kf[7], qr[3], C1, 0, 0, 0),   P1[14], P1[15], 0.f, 0.f,       pw3[2] = PKW(P1, 12), pw3[3] = PKW(P1, 14), pw3); \
    l_reg += sacc; \
    if (GK) { DMA_K((t) + 3, sl_cur); } if (GV) { DMA_V((t) + 1, sl_next); } \
    CMASK(C0, C1, t); \
    { float a = MX3(C0[0], C0[1], C1[0]), b_ = MX3(C0[2], C0[3], C1[1]); a = MX3(a, C1[2], C1[3]); \
      _Pragma("unroll") for (int r = 4; r < 16; r += 4) { a = MX3(a, C0[r], C0[r + 1]); b_ = MX3(b_, C0[r + 2], C0[r + 3]); a = MX3(a, C1[r], C1[r + 1]); b_ = MX3(b_, C1[r + 2], C1[r + 3]); } \
      float rm = __builtin_fmaxf(a, b_); { auto rr = __builtin_amdgcn_permlane32_swap(__float_as_uint(rm), __float_as_uint(rm), false, false); rm = __builtin_fmaxf(__uint_as_float(rr[0]), __uint_as_float(rr[1])); } \
      resc = false; \
      const bool valid_ = rm > -1e29f; const bool need_ = valid_ && (!started || rm > (float)THRL); \
      if (__builtin_expect(__any(need_), 0)) { const float dl = valid_ ? (started ? __builtin_fmaxf(rm, 0.f) : rm) : 0.f; mhat += dl; \
        _Pragma("unroll") for (int r = 0; r < 16; ++r) { C0[r] -= dl; C1[r] -= dl; } \
        const float f = started ? __builtin_amdgcn_exp2f(-dl) : 1.0f; l_reg *= f; if (hi == 0) wsf[r32] = f; resc = true; } \
      started = started || valid_; \
      if (resc || ((((t) + 1) & 3) == 0)) SETNEGM((t) + 1); } \
    SBAR(); \
    GAPB(o[0] = __builtin_amdgcn_mfma_f32_32x32x16_bf16(PAF(0), VFR(0), o[0], 0, 0, 0), C0, 0); \
    GAPB(o[1] = __builtin_amdgcn_mfma_f32_32x32x16_bf16(PAF(0), VFR(4), o[1], 0, 0, 0), C0, 4); \
    KRD(GL, 0); GAPB(o[0] = __builtin_amdgcn_mfma_f32_32x32x16_bf16(PAF(1), VFR(1), o[0], 0, 0, 0), C0, 8); \
    KRD(GL, 1); GAPB(o[1] = __builtin_amdgcn_mfma_f32_32x32x16_bf16(PAF(1), VFR(5), o[1], 0, 0, 0), C0, 12); \
    KRD(GL, 2); GAPB(o[0] = __builtin_amdgcn_mfma_f32_32x32x16_bf16(PAF(2), VFR(2), o[0], 0, 0, 0), C1, 0); \
    KRD(GL, 3); GAPB(o[1] = __builtin_amdgcn_mfma_f32_32x32x16_bf16(PAF(2), VFR(6), o[1], 0, 0, 0), C1, 4); \
    GAPB(o[0] = __builtin_amdgcn_mfma_f32_32x32x16_bf16(PAF(3), VFR(3), o[0], 0, 0, 0), C1, 8); \
    GAPB(o[1] = __builtin_amdgcn_mfma_f32_32x32x16_bf16(PAF(3), VFR(7), o[1], 0, 0, 0), C1, 12); \
    } while (0)
            int t = 1;
#undef CMASK
#define CMASK(P0, P1, t) do { } while (0)
            for (; t + 5 < NT; t += 2) {
                STEP(pB0, pB1, pA0, pA1, t, true, true, true);     WAIT_BAR(2); RESC(); ROT();
                STEP(pA0, pA1, pB0, pB1, t + 1, true, true, true); WAIT_BAR(2); RESC(); ROT();
            }
#undef CMASK
#define CMASK(P0, P1, t) do { int jb_ = (t) - (NT - 4); if (jb_ >= 0) cmask(P0, P1, jb_, qrel, hi); } while (0)
#define ENDW(tt) do { if ((tt) + 3 < NT) { WAIT_BAR(2); } else if ((tt) + 2 < NT) { WAIT_BAR(1); } else { WAIT_BAR(0); } } while (0)
            for (; t + 1 < NT; t += 2) {
                STEP(pB0, pB1, pA0, pA1, t, (t + 3 < NT), (t + 1 < NT), (t + 1 < NT));     ENDW(t);     RESC(); ROT();
                STEP(pA0, pA1, pB0, pB1, t + 1, (t + 4 < NT), (t + 2 < NT), (t + 2 < NT)); ENDW(t + 1); RESC(); ROT();
            }
            const bool more = jbo + 1 < NBLK;
            if (more) { DMA_K(0, sl_next); DMA_V(0, sl_next); DMA_K(1, sl_prev); DMA_K(2, sl_cur); ring0 = sl_next; }
            STEP(pB0, pB1, pA0, pA1, NT - 1, false, false, false); RESC();
            if (more) { const bf16_t* Qn = Qw + (size_t)MBLK * ATT_W;
#pragma unroll
                for (int d0 = 0; d0 < 4; ++d0) qr[d0] = *(const bf16x8*)(Qn + (size_t)r32 * ATT_W + d0 * 16 + hi * 8); }
            { float sacc = pB0[0] + pB0[1];
#pragma unroll
              for (int r = 2; r < 16; ++r) sacc += pB0[r];
#pragma unroll
              for (int r = 0; r < 16; ++r) sacc += pB1[r];
              l_reg += sacc;
              pw0 = (u32x4){PKW(pB0, 0), PKW(pB0, 2), PKW(pB0, 4), PKW(pB0, 6)}; pw1 = (u32x4){PKW(pB0, 8), PKW(pB0, 10), PKW(pB0, 12), PKW(pB0, 14)};
              pw2 = (u32x4){PKW(pB1, 0), PKW(pB1, 2), PKW(pB1, 4), PKW(pB1, 6)}; pw3 = (u32x4){PKW(pB1, 8), PKW(pB1, 10), PKW(pB1, 12), PKW(pB1, 14)};
              SBAR(); pv(o, vb0 + sl_cur, PAF(0), PAF(1), PAF(2), PAF(3)); }
#undef PKW
#undef PAF
#undef VFR
#undef PIN
#undef MX3
#undef GAPA
#undef GAPB
#undef EX
#undef VRD
#undef KRD
#undef STEP
#undef ENDW
            { auto rr = __builtin_amdgcn_permlane32_swap(__float_as_uint(l_reg), __float_as_uint(l_reg), false, false); l_reg = __uint_as_float(rr[0]) + __uint_as_float(rr[1]); }
            if (hi == 0) wsf[32 + r32] = l_reg; asm volatile("s_waitcnt lgkmcnt(0)" ::: "memory");
            bf16_t* Ow = O + ((size_t)(b * SEQ + q0 + wid * 32)) * ATT_W + h * HD;
            { LAS bf16_t* stg = (LAS bf16_t*)(lds + L_OST) + wid * 2048;
#pragma unroll
              for (int r = 0; r < 16; ++r) { const int orow = crow(r, hi); const float rl = __builtin_amdgcn_rcpf(wsf[32 + orow]);
                  stg[orow * 64 + r32] = (bf16_t)(pk_bf16(o[0][r] * rl, 0.f) & 0xffffu); stg[orow * 64 + 32 + r32] = (bf16_t)(pk_bf16(o[1][r] * rl, 0.f) & 0xffffu); }
              asm volatile("s_waitcnt lgkmcnt(0)" ::: "memory");
#pragma unroll
              for (int i = 0; i < 4; ++i) { const int row = i * 8 + (lane >> 3), ch = lane & 7; const u32x4 v = *(const LAS u32x4*)(stg + row * 64 + ch * 8); *(u32x4*)(Ow + (size_t)row * ATT_W + ch * 8) = v; } }
            asm volatile("s_waitcnt lgkmcnt(0)\n\ts_barrier" ::: "memory");
#undef CMASK
#undef SETNEGM
#undef START
#undef RESC
#undef ROT
        }
#undef DMA_K
#undef DMA_V
#undef NXT
    }
}
#undef SBAR
#undef WAIT_BAR
}

#define XB_TMO      128
#define XB_XCNT(j)  (256  + 64 * (j))
#define XB_XSUB(j)  (1280 + 64 * (j))
#define XB_XGEN(j)  (2304 + 64 * (j))
#define XB_TOP      3328
#define XB_TOPGEN   3392
#define XCD_BAR_WORDS 3456
#define XB_SPIN_CAP (1u << 20)
__device__ __forceinline__ unsigned xb_ld(unsigned* p)              { return __hip_atomic_load(p, __ATOMIC_RELAXED, __HIP_MEMORY_SCOPE_AGENT); }
__device__ __forceinline__ unsigned xb_add(unsigned* p, unsigned v) { return __hip_atomic_fetch_add(p, v, __ATOMIC_RELAXED, __HIP_MEMORY_SCOPE_AGENT); }
__device__ __forceinline__ unsigned xb_xcc_id() { return (unsigned)__builtin_amdgcn_s_getreg((3 << 11) | 20) & 0xFu; }
#define XB_SPIN(cond, bar) do { unsigned _sp = 0; while (cond) { __builtin_amdgcn_s_sleep(1); \
    if ((++_sp & 255u) == 0u) { if (xb_ld(&(bar)[XB_TMO])) break; if (_sp > XB_SPIN_CAP) { atomicAdd(&(bar)[XB_TMO], 1u); break; } } } } while (0)
struct XcdBarrier { unsigned* bar; unsigned x; volatile LAS unsigned* st; };
__device__ __forceinline__ XcdBarrier xcd_barrier_post(unsigned* bar, volatile LAS unsigned* st) {
    XcdBarrier b; b.bar = bar; b.x = xb_xcc_id(); b.st = st;
    if (threadIdx.x == 0) (void)xb_add(&bar[XB_XCNT(b.x)], 1u);
    return b;
}
__device__ __forceinline__ void xcd_barrier_complete(unsigned* bar, unsigned x, unsigned& nloc, unsigned& nx) {
    const unsigned G = gridDim.x * gridDim.y * gridDim.z;
    unsigned sum, cnt, mine, sp = 0u;
    for (;;) {
        sum = 0u; cnt = 0u; mine = 0u;
#pragma unroll
        for (unsigned j = 0; j < 16; ++j) { const unsigned c = xb_ld(&bar[XB_XCNT(j)]); sum += c; cnt += (c > 0u) ? 1u : 0u; mine = (j == x) ? c : mine; }
        if (sum == G) break;
        __builtin_amdgcn_s_sleep(1);
        if ((++sp & 255u) == 0u) { if (xb_ld(&bar[XB_TMO])) break; if (sp > XB_SPIN_CAP) { atomicAdd(&bar[XB_TMO], 1u); break; } }
    }
    nloc = mine > 0u ? mine : 1u; nx = cnt > 0u ? cnt : 1u;
}
__device__ __forceinline__ void xcd_barrier(const XcdBarrier& b) {
    asm volatile("s_waitcnt vmcnt(0)" ::: "memory");
    __syncthreads();
    if (threadIdx.x == 0) {
        unsigned* bar = b.bar;
        __builtin_amdgcn_s_waitcnt(0);
        unsigned nloc = b.st[0], nx = b.st[1];
        if (nloc == 0u) { xcd_barrier_complete(bar, b.x, nloc, nx); b.st[0] = nloc; b.st[1] = nx; }
        const unsigned old = xb_add(&bar[XB_XSUB(b.x)], 1u);
        const unsigned gen = old / nloc;
        if (old + 1u == (gen + 1u) * nloc) {
            __builtin_amdgcn_fence(__ATOMIC_RELEASE, "agent");
            asm volatile("s_waitcnt vmcnt(0)" ::: "memory");
            const unsigned og = xb_add(&bar[XB_TOP], 1u);
            const unsigned tg = og / nx;
            if (og + 1u == (tg + 1u) * nx) xb_add(&bar[XB_TOPGEN], 1u);
            else XB_SPIN(xb_ld(&bar[XB_TOPGEN]) == tg, bar);
            __builtin_amdgcn_fence(__ATOMIC_ACQUIRE, "agent");
            xb_add(&bar[XB_XGEN(b.x)], 1u);
            asm volatile("s_waitcnt vmcnt(0)" ::: "memory");
        } else {
            XB_SPIN(xb_ld(&bar[XB_XGEN(b.x)]) == gen, bar);
            __builtin_amdgcn_fence(__ATOMIC_ACQUIRE, "agent");
            asm volatile("s_waitcnt vmcnt(0)" ::: "memory");
        }
    }
    __syncthreads();
}

#ifndef MK_SWAP1415
#define MK_SWAP1415 1
#endif
#ifndef MK_ST13_STATIC
#define MK_ST13_STATIC 1
#endif
constexpr int N_STAGES = 18;
__device__ __forceinline__ void wg_seam() {
    asm volatile("s_waitcnt vmcnt(0)" ::: "memory");
    __syncthreads();
    if (threadIdx.x < 64) { __builtin_amdgcn_fence(__ATOMIC_ACQUIRE, "agent"); asm volatile("s_waitcnt vmcnt(0)" ::: "memory"); }
    __syncthreads();
}
template <class Epi>
__device__ __forceinline__ void run_gemm(LAS unsigned char* lds, const bf16_t* A, int lda, const bf16_t* Bt, int ldb, int K, int nM, int nN, int pmPerGroup, size_t gstrideB, const Epi& E) {
    pg8::Gemm g{A, Bt, lda, ldb, K, nM, nN, pmPerGroup, gstrideB};
    const int pm = blockIdx.x;
    if (pm < nM) { pg8::PanelOrder S{pm, nN}; pg8::gemm_phase<Epi, pg8::PanelOrder>(lds, g, S, E); }
}
#ifndef MK_PHMASK
#define MK_PHMASK 0x3ffff
#endif
#define PH_ON(k) (((MK_PHMASK) >> (k)) & 1)
constexpr int NM = M_TOK / 256;

__device__ __forceinline__ void stage_hnorm(PArg P, int nwv) {
    const int lane = threadIdx.x & 63, wave = __builtin_amdgcn_readfirstlane(threadIdx.x >> 6);
    if (wave >= nwv) return;
    const int rpw = 256 / nwv;
    const float* x = P.in(I_X); bf16_t* xb = (bf16_t*)P.out(); float* r0 = (float*)(P.ws() + WS_R0);
    for (int pm = blockIdx.x; pm < NM; pm += gridDim.x)
        for (int i = 0; i < rpw; i += 4) {
            const int m0 = pm * 256 + wave * rpw + i;
            f32x4 v[4][4];
#pragma unroll
            for (int r = 0; r < 4; ++r) { const f32x4* xr = (const f32x4*)(x + (size_t)(m0 + r) * DM) + 2 * lane;
#pragma unroll
                for (int j = 0; j < 2; ++j) { v[r][2 * j] = xr[128 * j]; v[r][2 * j + 1] = xr[128 * j + 1]; } }
#pragma unroll
            for (int r = 0; r < 4; ++r) { float s = 0.f;
#pragma unroll
                for (int j = 0; j < 2; ++j) { const f32x4 a = v[r][2 * j], b = v[r][2 * j + 1];
                    s += (a.x * a.x + a.y * a.y) + (a.z * a.z + a.w * a.w) + (b.x * b.x + b.y * b.y) + (b.z * b.z + b.w * b.w);
                    u32x4 w; w.x = pk_bf16(a.x, a.y); w.y = pk_bf16(a.z, a.w); w.z = pk_bf16(b.x, b.y); w.w = pk_bf16(b.z, b.w); ((u32x4*)(xb + (size_t)(m0 + r) * DM))[lane + 64 * j] = w; }
                const float rr = rsqrtf(wave_sum(s) * (1.0f / DM) + RMS_EPS); if (lane == 0) r0[m0 + r] = rr; }
        }
}
__device__ __forceinline__ void stage_scan(PArg P) {
    const int tid = threadIdx.x; if (tid >= 256) return;
    const float* E = (const float*)(P.ws() + WS_E); bf16_t* Ap = (bf16_t*)(P.ws() + WS_AP); const float* AL = (const float*)(P.ws() + WS_AL);
    for (int pm = blockIdx.x; pm < NG * NROW_G / 256; pm += gridDim.x) {
        const int p = tid & 63, g = pm >> 3, b = 4 * (pm & 7) + (tid >> 6);
        const float ar = AL[(g * 64 + p) * 2], ai = AL[(g * 64 + p) * 2 + 1];
        float xr = 0.f, xi = 0.f; const size_t row0 = (size_t)g * NROW_G + (size_t)b * NCH;
        for (int k0 = 0; k0 < NCH; k0 += 8) {
            float er[8], ei[8];
#pragma unroll
            for (int k = 0; k < 8; ++k) { er[k] = E[(row0 + k0 + k) * 128 + p]; ei[k] = E[(row0 + k0 + k) * 128 + 64 + p]; }
#pragma unroll
            for (int k = 0; k < 8; ++k) {
                bf16_t* d = Ap + (row0 + k0 + k) * APK + p;
                d[0] = (bf16_t)(pk_bf16(xr, 0.f) & 0xffffu); d[64] = (bf16_t)(pk_bf16(xi, 0.f) & 0xffffu);
                const float nr = ar * xr - ai * xi + er[k], ni = ar * xi + ai * xr + ei[k]; xr = nr; xi = ni; }
        }
    }
}
#ifndef MK_EWR
#define MK_EWR 4
#endif
constexpr int EWR = MK_EWR;
template <int MODE>
__device__ __forceinline__ void stage_ew(PArg P, const bf16_t* XB, const bf16_t* Y, const float* g1, bf16_t* OB) {
    const int tid = threadIdx.x, lane = tid & 63, wave = tid >> 6;
    const float* rsq = (const float*)(P.ws() + WS_RSQ); float* r2o = (float*)(P.ws() + WS_R2); float* outf = P.out();
    f32x4 gv[2][2];
#pragma unroll
    for (int j = 0; j < 2; ++j) { gv[j][0] = *(const f32x4*)(g1 + (lane + 64 * j) * 8); gv[j][1] = *(const f32x4*)(g1 + (lane + 64 * j) * 8 + 4); }
    for (int pm = blockIdx.x; pm < NM; pm += gridDim.x) {
        for (int i = 0; i < 32; i += EWR) {
            const int m0 = pm * 256 + wave * 32 + i;
            u32x4 xw[EWR][2], yw[EWR][2]; float rs[EWR];
#pragma unroll
            for (int r = 0; r < EWR; ++r) { rs[r] = (lane < 16) ? rsq[(size_t)(m0 + r) * 16 + lane] : 0.f;
#pragma unroll
                for (int j = 0; j < 2; ++j) { const size_t e = (size_t)(m0 + r) * DM + (size_t)(lane + 64 * j) * 8; xw[r][j] = *(const u32x4*)(XB + e); yw[r][j] = *(const u32x4*)(Y + e); } }
#pragma unroll
            for (int r = 0; r < EWR; ++r) {
                const float rn = rsqrtf(wave_sum(rs[r]) * (1.0f / DM) + RMS_EPS);
                float s = 0.f;
#pragma unroll
                for (int j = 0; j < 2; ++j) {
                    const size_t e = (size_t)(m0 + r) * DM + (size_t)(lane + 64 * j) * 8;
                    float xv[8], yv[8], v[8]; unpack8(xw[r][j], xv); unpack8(yw[r][j], yv);
#pragma unroll
                    for (int k = 0; k < 4; ++k) { v[k] = xv[k] + yv[k] * rn * gv[j][0][k]; v[4 + k] = xv[4 + k] + yv[4 + k] * rn * gv[j][1][k]; }
                    if (MODE == 2) { *(f32x4*)(outf + e) = (f32x4){v[0], v[1], v[2], v[3]}; *(f32x4*)(outf + e + 4) = (f32x4){v[4], v[5], v[6], v[7]}; }
                    else { u32x4 w; w.x = pk_bf16(v[0], v[1]); w.y = pk_bf16(v[2], v[3]); w.z = pk_bf16(v[4], v[5]); w.w = pk_bf16(v[6], v[7]); *(u32x4*)(OB + e) = w; }
                    if (MODE == 0) {
#pragma unroll
                        for (int k = 0; k < 8; ++k) s += v[k] * v[k]; }
                }
                if (MODE == 0) { const float r2 = rsqrtf(wave_sum(s) * (1.0f / DM) + RMS_EPS); if (lane == 0) r2o[m0 + r] = r2; }
            }
        }
    }
}

__device__ __forceinline__ void stage_pconv(PArg P) {
    const int tid = threadIdx.x;
    for (int pm = blockIdx.x; pm < NM; pm += gridDim.x) {
        const f32x4* ps = (const f32x4*)(P.in(I_P) + (size_t)pm * 256 * PLE); u32x2* pd = (u32x2*)((bf16_t*)(P.ws() + WS_PB) + (size_t)pm * 256 * PLE);
#pragma unroll 4
        for (int i2 = tid; i2 < 256 * PLE / 4; i2 += NTHR) { const f32x4 v = ps[i2]; u32x2 w; w.x = pk_bf16(v.x, v.y); w.y = pk_bf16(v.z, v.w); pd[i2] = w; }
    }
}
__device__ __forceinline__ void grid_sync_probe() { cg::this_grid().sync(); }
__device__ __forceinline__ void run_stage(PArg P, LAS unsigned char* lds, int st) {
    unsigned char* ws = P.ws();
#define WSB(off) ((bf16_t*)(ws + (off)))
    switch (st) {
#if defined(MK_P0MODE)
    case 0: if constexpr (PH_ON(0)) { int nrep_ = MK_P0N; asm volatile("" : "+s"(nrep_)); for (int r_ = 0; r_ < nrep_; ++r_) { if (MK_P0MODE == 1) stage_hnorm(P, 8); else phase_prep(P, lds, MK_P0MODE - 1, 0); __syncthreads(); } }
            if constexpr (PH_ON(0)) { if (blockIdx.x & 1) { stage_hnorm(P, 8); __syncthreads(); phase_prep(P, lds, 3, 0); } else { phase_prep(P, lds, 3, 0); stage_hnorm(P, 8); } } break;
#elif MK_HNW == 8
    case 0: if constexpr (PH_ON(0)) { if (blockIdx.x & 1) { stage_hnorm(P, 8); __syncthreads(); phase_prep(P, lds, 3, 0); } else { phase_prep(P, lds, 3, 0); stage_hnorm(P, 8); } } break;
#else
    case 0: if constexpr (PH_ON(0)) { phase_prep(P, lds, 1, 0); stage_hnorm(P, MK_HNW); phase_prep(P, lds, 2, MK_HNW); } break;
#endif
    case 1: break;
    case 2: if constexpr (PH_ON(2)) { EpiIn E{WSB(WS_AP), WSB(WS_Q), WSB(WS_K), WSB(WS_V), WSB(WS_GA), WSB(WS_GB), (float*)(ws + WS_KMEAN), (const float*)(ws + WS_R0)};
#if MK_ST2_STATIC
              { pg8::Gemm g{(const bf16_t*)P.out(), WSB(WS_WIN), DM, DM, DM, NM, INC / 256, NM, 0}; pg8::StaticOrder S; S.init(NM, INC / 256, (int)gridDim.x, (int)blockIdx.x);
                pg8::gemm_phase<EpiIn, pg8::StaticOrder>(lds, g, S, E); } } break;
#else
              run_gemm(lds, (const bf16_t*)P.out(), DM, WSB(WS_WIN), DM, DM, NM, INC / 256, NM, 0, E); } break;
#endif
    case 3: if constexpr (PH_ON(3)) { EpiSsm1 E{(float*)(ws + WS_E)};
              run_gemm(lds, WSB(WS_AP) + 128, APK, WSB(WS_WS1), 512, 512, NG * NROW_G / 256, 1, NROW_G / 256, (size_t)256 * 512, E); } break;
    case 4: if constexpr (PH_ON(4)) stage_scan(P); break;
    case 5: if constexpr (PH_ON(5)) { EpiSsm2 E{WSB(WS_AP), P.in(I_DSK), WSB(WS_Y)};
              run_gemm(lds, WSB(WS_AP), APK, WSB(WS_WS2), APK, APK, NG * NROW_G / 256, 2, NROW_G / 256, (size_t)512 * APK, E); } break;
    case 6: if constexpr (PH_ON(6)) {
#if defined(MK_APROBE)
              att::attn_phase<MK_APROBE>(P, lds); __syncthreads();
#endif
#if MK_ATT2
#if defined(MK_APROBE2)
              { int nrep = MK_APREP; asm volatile("" : "+s"(nrep)); for (int i = 0; i < nrep; ++i) { att2::attn_phase<MK_THRL, MK_APROBE2>(P, lds); __syncthreads(); } }
#endif
              att2::attn_phase<MK_THRL, 0>(P, lds); } break;
#else
#if defined(MK_APREP)
              { int nrep = MK_APREP; asm volatile("" : "+s"(nrep)); for (int i = 0; i < nrep; ++i) { att::attn_phase<0>(P, lds); __syncthreads(); } }
#endif
              att::attn_phase<0>(P, lds); } break;
#endif
    case 7: if constexpr (PH_ON(7)) { EpiGen<EM_GLU, false> E{WSB(WS_GLU), SSM_W, WSB(WS_Y), nullptr, P.in(I_BGLU), nullptr};
              run_gemm(lds, WSB(WS_Y), SSM_W, WSB(WS_WGLU), SSM_W, SSM_W, NM, SSM_W / 256, NM, 0, E); } break;
    case 8: if constexpr (PH_ON(8)) { EpiGen<EM_GATE, false> E{WSB(WS_T1), DM, WSB(WS_GA), nullptr, nullptr, nullptr};
              run_gemm(lds, WSB(WS_GLU), SSM_W, WSB(WS_WA), SSM_W, SSM_W, NM, DM / 256, NM, 0, E); } break;
    case 9: if constexpr (PH_ON(9)) { EpiGen<EM_GATEADD, false> E{WSB(WS_MIXIN), DM, WSB(WS_GB), WSB(WS_T1), nullptr, nullptr};
              run_gemm(lds, WSB(WS_ATT), ATT_W, WSB(WS_WB), ATT_W, ATT_W, NM, DM / 256, NM, 0, E); } break;
    case 10: if constexpr (PH_ON(10)) { EpiGen<EM_PLAIN, true> E{WSB(WS_MIXED), DM, nullptr, nullptr, nullptr, (float*)(ws + WS_RSQ)};
              run_gemm(lds, WSB(WS_MIXIN), DM, WSB(WS_WOUT), DM, DM, NM, DM / 256, NM, 0, E); } break;
    case 11: if constexpr (PH_ON(11)) stage_ew<0>(P, (const bf16_t*)P.out(), WSB(WS_MIXED), P.in(I_GPOSTMIX), WSB(WS_H)); break;
    case 12: if constexpr (PH_ON(12)) {
#if defined(MK_PROBE) && (MK_PROBE == 2)
               { EpiGen<EM_PLAIN, false> EN{WSB(WS_HID), 256, nullptr, nullptr, nullptr, nullptr}; run_gemm(lds, WSB(WS_H), DM, WSB(WS_W1), DM, DM, NM, DFF / 256, NM, 0, EN); }
#elif defined(MK_PROBE)
               { EpiProbe<MK_PROBE> EN{nullptr}; run_gemm(lds, WSB(WS_H), DM, WSB(WS_W1), DM, DM, NM, DFF / 256, NM, 0, EN); }
#endif
               EpiGen<EM_RELU2, false> E{WSB(WS_HID), HID_LD, nullptr, nullptr, (const float*)(ws + WS_R2), nullptr};
#if MK_ST12_STATIC
               { pg8::Gemm g{WSB(WS_H), WSB(WS_W1), DM, DM, DM, NM, DFF / 256, NM, 0}; pg8::StaticOrder S; S.init(NM, DFF / 256, (int)gridDim.x, (int)blockIdx.x);
                 pg8::gemm_phase<EpiGen<EM_RELU2, false>, pg8::StaticOrder>(lds, g, S, E); } } break;
#else
               run_gemm(lds, WSB(WS_H), DM, WSB(WS_W1), DM, DM, NM, DFF / 256, NM, 0, E); } break;
#endif
    case 13: if constexpr (PH_ON(13)) {
#if defined(MK_PROBE13) && (MK_PROBE13 == 1)
               { EpiProbe<0> EN{nullptr}; run_gemm(lds, WSB(WS_HID), HID_LD, WSB(WS_W2), DFF, DFF, NM, DM / 256, NM, 0, EN); }
#elif defined(MK_PROBE13) && (MK_PROBE13 == 2)
               { EpiProbe<0> EN{nullptr}; pg8::Gemm g{WSB(WS_HID), WSB(WS_W2), HID_LD, DFF, DFF, NM, DM / 256, NM, 0}; pg8::StaticOrder S; S.init(NM, DM / 256, (int)gridDim.x, (int)blockIdx.x); grid_sync_probe(); pg8::gemm_phase<EpiProbe<0>, pg8::StaticOrder>(lds, g, S, EN); }
#endif
               EpiGen<EM_PLAIN, true> E{WSB(WS_F), DM, nullptr, nullptr, nullptr, (float*)(ws + WS_RSQ)};
#if MK_ST13_STATIC
               { pg8::Gemm g{WSB(WS_HID), WSB(WS_W2), HID_LD, DFF, DFF, NM, DM / 256, NM, 0}; pg8::StaticOrder S; S.init(NM, DM / 256, (int)gridDim.x, (int)blockIdx.x);
                 pg8::gemm_phase<EpiGen<EM_PLAIN, true>, pg8::StaticOrder>(lds, g, S, E); } } break;
#else
               run_gemm(lds, WSB(WS_HID), HID_LD, WSB(WS_W2), DFF, DFF, NM, DM / 256, NM, 0, E); } break;
#endif
    case 14: if constexpr (PH_ON(14)) stage_ew<1>(P, WSB(WS_H), WSB(WS_F), P.in(I_GPOSTMLP), WSB(WS_X2B)); break;
    case 15: if constexpr (PH_ON(15)) { stage_pconv(P); wg_seam(); EpiGen<EM_PLAIN, false> E{WSB(WS_PW), DM, nullptr, nullptr, nullptr, nullptr};
               run_gemm(lds, WSB(WS_PB), PLE, WSB(WS_WPLE), PLE, PLE, NM, DM / 256, NM, 0, E); } break;
    case 16: if constexpr (PH_ON(16)) { EpiGen<EM_MULSIG, true> E{WSB(WS_EE), DM, WSB(WS_PW), nullptr, nullptr, (float*)(ws + WS_RSQ)};
               run_gemm(lds, WSB(WS_X2B), DM, WSB(WS_WPG), DM, DM, NM, DM / 256, NM, 0, E); } break;
    case 17: if constexpr (PH_ON(17)) stage_ew<2>(P, WSB(WS_X2B), WSB(WS_EE), P.in(I_GPLE), nullptr); break;
    default: break;
    }
#undef WSB
}

__global__ void __launch_bounds__(NTHR, 2) mk_fwd(Params Pval) {
    extern __shared__ __attribute__((aligned(16))) unsigned char lds_raw[];
    LAS unsigned char* lds = (LAS unsigned char*)lds_raw;
    {
        const __attribute__((address_space(4))) unsigned* ka = (const __attribute__((address_space(4))) unsigned*)__builtin_amdgcn_kernarg_segment_ptr();
        if (threadIdx.x < 54) ((LAS unsigned*)(lds + LDS_PARAM_OFF))[threadIdx.x] = ka[threadIdx.x];
        else if (threadIdx.x < 64) ((LAS unsigned*)(lds + LDS_PARAM_OFF))[threadIdx.x] = 0u;
        __syncthreads();
    }
    const PArg P{(const LAS unsigned*)(lds + LDS_PARAM_OFF)};
#ifndef MK_XCDBAR
#define MK_XCDBAR 1
#endif
    XcdBarrier xbar = xcd_barrier_post((unsigned*)(P.ws() + WS_BAR), (volatile LAS unsigned*)(lds + LDS_PARAM_OFF + 224));
    cg::grid_group grid = cg::this_grid();
#ifndef MK_REPMASK
#define MK_REPMASK 0
#endif
#ifndef MK_REPN
#define MK_REPN 1
#endif
#define MK_SYNC(k, GRIDSYNC) { if (GRIDSYNC) { if (MK_XCDBAR && Pval.ph_hi <= N_STAGES) xcd_barrier(xbar); else grid.sync(); } else wg_seam(); }
#define MK_STAGE(k, GRIDSYNC) if (Pval.ph_lo <= (k) && (k) < Pval.ph_hi) { \
        if constexpr (((MK_REPMASK) >> (k)) & 1) { int nrep_ = MK_REPN; asm volatile("" : "+s"(nrep_)); for (int r_ = 0; r_ < nrep_; ++r_) { run_stage(P, lds, (k)); MK_SYNC(k, GRIDSYNC) } }     \
        run_stage(P, lds, (k)); if ((k) + 1 < Pval.ph_hi) MK_SYNC(k, GRIDSYNC) }
    MK_STAGE(0, true) MK_STAGE(1, false) MK_STAGE(2, true) MK_STAGE(3, false) MK_STAGE(4, false) MK_STAGE(5, false) MK_STAGE(6, true)
    MK_STAGE(7, false) MK_STAGE(8, false) MK_STAGE(9, false) MK_STAGE(10, false) MK_STAGE(11, true) MK_STAGE(12, MK_ST13_STATIC != 0) MK_STAGE(13, MK_ST13_STATIC != 0)
    if (Pval.ph_lo <= 14 && 16 <= Pval.ph_hi && MK_SWAP1415 && ((blockIdx.x >> 3) & 1)) {
        run_stage(P, lds, 15); wg_seam(); run_stage(P, lds, 14); if (16 < Pval.ph_hi) wg_seam();
    } else { MK_STAGE(14, false) MK_STAGE(15, false) }
    MK_STAGE(16, false) MK_STAGE(17, false)
#undef MK_STAGE
#undef MK_SYNC
}


extern "C" void kernel_launch(void* const* d_in, const int* in_sizes, int n_in, void* d_out, int out_size, void* d_ws, size_t ws_size, hipStream_t stream) {
    static int grid = 0;
    if (grid == 0) {
        if (n_in != 25 || out_size != M_TOK * DM || ws_size < WS_END) { fprintf(stderr, "kernel_launch: unexpected shapes (n_in %d out %d ws %zu)\n", n_in, out_size, ws_size); grid = -1; return; }
        int dev = 0, cus = 0, per_cu = 0;
        hipGetDevice(&dev); hipDeviceGetAttribute(&cus, hipDeviceAttributeMultiprocessorCount, dev);
        hipFuncSetAttribute((const void*)mk_fwd, hipFuncAttributeMaxDynamicSharedMemorySize, LDS_BYTES);
        hipOccupancyMaxActiveBlocksPerMultiprocessor(&per_cu, (const void*)mk_fwd, NTHR, LDS_BYTES);
        if (per_cu < 1) { fprintf(stderr, "kernel_launch: occupancy query says %d blocks/CU\n", per_cu); per_cu = 1; }
        grid = NM_PANELS;
        if (cus != NM_PANELS) fprintf(stderr, "kernel_launch: device reports %d CUs; this kernel is laid out for %d\n", cus, NM_PANELS);
        (void)hipGetLastError();
    }
    if (grid < 0) return;
    Params p{};
    for (int i = 0; i < 25; ++i) p.in[i] = (const float*)d_in[i];
    p.out = (float*)d_out; p.ws = (unsigned char*)d_ws;
    (void)hipMemsetAsync((char*)d_ws + WS_BAR, 0, 16384, stream);
#if MK_DEBUG
    dbg_run(p, grid, stream);
#elif MK_LAUNCHES == 1
    p.ph_lo = 0; p.ph_hi = N_STAGES;
    void* args[] = {&p};
    hipError_t e = hipLaunchCooperativeKernel((const void*)mk_fwd, dim3(grid), dim3(NTHR), args, LDS_BYTES, stream);
    if (e != hipSuccess) fprintf(stderr, "cooperative launch failed: %s (grid %d)\n", hipGetErrorString(e), grid);
#else
    for (int ph = 0; ph < N_STAGES; ++ph) { p.ph_lo = ph; p.ph_hi = ph + 1; hipLaunchKernelGGL(mk_fwd, dim3(grid), dim3(NTHR), LDS_BYTES, stream, p); }
#endif
}
```
